# Optimizing an MI355X kernel written in HIP

```python
import jax, jax.numpy as jnp
from jax import lax
import numpy as np


D_MODEL = 1024
BATCH = 8
SEQ = 4096
DEPTH = 4

BRANCH_WIDTH = D_MODEL // 2
HEAD_DIM = 64
N_BRANCH = 4
CONV_WIDTH_A = BRANCH_WIDTH
CONV_K = 3
NSA_HEADS = BRANCH_WIDTH // HEAD_DIM
NSA_KV_GROUPS = 2
NSA_REP = NSA_HEADS // NSA_KV_GROUPS
NSA_WIDTH = NSA_HEADS * HEAD_DIM
KV_WIDTH = NSA_KV_GROUPS * HEAD_DIM
CMP_BLOCK = 32
CMP_STRIDE = 16
SLC_BLOCK = 64
SLC_TOPN = 16
WIN = 512
Q_BLOCK = 128
NEG = -1e30
FORCE = 1e6
POOL_WINDOWS = (2, 4, 8, 16)
POOL_GROUPS = len(POOL_WINDOWS)
POOL_GROUP_DIM = BRANCH_WIDTH // POOL_GROUPS
POOL_WIDTH = BRANCH_WIDTH
SGU_CHUNK = 128
SGU_GROUPS = 4
SGU_WIDTH = BRANCH_WIDTH
SGU_GROUP_DIM = SGU_WIDTH // SGU_GROUPS
D_FF = 2816
FF_CONV_K = 3
RMS_EPS = 1e-6
IN_SPLITS = (CONV_WIDTH_A, CONV_WIDTH_A, CONV_WIDTH_A, NSA_WIDTH, 6 * KV_WIDTH, 3 * NSA_HEADS,
             POOL_WIDTH, 2 * SGU_WIDTH, N_BRANCH * D_MODEL)
N_IN = sum(IN_SPLITS)

kernel_name = 'hybrid_gated_parallel_mixer'


def rms_norm(x, g, eps=RMS_EPS):
    xf = x.astype(jnp.float32)
    y = xf * lax.rsqrt(jnp.mean(xf * xf, axis=-1, keepdims=True) + eps)
    return (y * g.astype(jnp.float32)).astype(x.dtype)


def causal_dwconv(x, w):
    k, s = w.shape[0], x.shape[1]
    xp = jnp.pad(x, ((0, 0), (k - 1, 0), (0, 0)))
    return sum(w[j] * xp[:, j:j + s] for j in range(k))


def split_columns(z):
    offs, acc = [], 0
    for n in IN_SPLITS[:-1]:
        acc += n
        offs.append(acc)
    return jnp.split(z, offs, axis=-1)


def overlap_matrix(n_cmp, n_slc):
    cs = np.arange(n_cmp) * CMP_STRIDE
    ce = cs + CMP_BLOCK
    ss = np.arange(n_slc) * SLC_BLOCK
    se = ss + SLC_BLOCK
    ov = np.minimum(ce[:, None], se[None]) - np.maximum(cs[:, None], ss[None])
    return np.clip(ov, 0, None).astype(np.float32) / CMP_BLOCK


def nsa_mixer(q, kv, gates, qk_g, cmp_pe, cmp_w1, cmp_w2):
    b, s, _ = q.shape
    g_, r_, dk = NSA_KV_GROUPS, NSA_REP, HEAD_DIM
    q = rms_norm(q.reshape(b, s, g_, r_, dk), qk_g[0])
    kv = kv.reshape(b, s, 6, g_, dk)
    k_c, v_c, k_s, v_s, k_w, v_w = [kv[:, :, i] for i in range(6)]
    n_cmp = (s - CMP_BLOCK) // CMP_STRIDE + 1
    cidx = np.arange(n_cmp)[:, None] * CMP_STRIDE + np.arange(CMP_BLOCK)[None]

    def compress(t, j):
        blk = t[:, cidx] + cmp_pe[j][None, None, :, None, :]
        flat = blk.transpose(0, 1, 3, 2, 4).reshape(b, n_cmp, g_, CMP_BLOCK * dk)
        return jax.nn.silu(flat @ cmp_w1[j]) @ cmp_w2[j]

    kc = rms_norm(compress(k_c, 0), qk_g[1])
    vc = compress(v_c, 1)
    c_end = jnp.asarray(cidx[:, -1])
    n_slc = s // SLC_BLOCK
    top_n = min(SLC_TOPN, n_slc)
    ks = rms_norm(k_s, qk_g[2]).reshape(b, n_slc, SLC_BLOCK, g_, dk).transpose(0, 3, 1, 2, 4)
    vs = v_s.reshape(b, n_slc, SLC_BLOCK, g_, dk).transpose(0, 3, 1, 2, 4)
    ov = jnp.asarray(overlap_matrix(n_cmp, n_slc))
    pad = ((0, 0), (WIN, 0), (0, 0), (0, 0))
    kw = jnp.pad(rms_norm(k_w, qk_g[3]), pad)
    vw = jnp.pad(v_w, pad)
    scale = HEAD_DIM ** -0.5
    bi = jnp.arange(b)[:, None, None, None]
    gi = jnp.arange(g_)[None, None, :, None]
    jblk = jnp.arange(n_slc)

    def block(i):
        start = i * Q_BLOCK
        qb = lax.dynamic_slice_in_dim(q, start, Q_BLOCK, axis=1)
        t = start + jnp.arange(Q_BLOCK)
        sc = jnp.einsum('bqgrd,bngd->bqgrn', qb, kc).astype(jnp.float32) * scale
        cval = c_end[None, :] <= t[:, None]
        pc = jax.nn.softmax(jnp.where(cval[None, :, None, None, :], sc, NEG), axis=-1)
        pc = pc * jnp.any(cval, axis=-1)[None, :, None, None, None]
        o_c = jnp.einsum('bqgrn,bngd->bqgrd', pc.astype(vc.dtype), vc)
        imp = jnp.einsum('bqgrn,nj->bqgj', pc, ov)
        jt = (t // SLC_BLOCK)[:, None]
        future = jblk[None, :] > jt
        forced = (jblk[None, :] == 0) | (jblk[None, :] == jt) | (jblk[None, :] == jt - 1)
        imp = jnp.where(forced[None, :, None, :], FORCE, jnp.where(future[None, :, None, :], NEG, imp))
        _, idx = lax.top_k(imp, top_n)
        ksel = ks[bi, gi, idx].reshape(b, Q_BLOCK, g_, top_n * SLC_BLOCK, dk)
        vsel = vs[bi, gi, idx].reshape(b, Q_BLOCK, g_, top_n * SLC_BLOCK, dk)
        kpos = (idx[..., None] * SLC_BLOCK + jnp.arange(SLC_BLOCK)).reshape(b, Q_BLOCK, g_, top_n * SLC_BLOCK)
        ss_ = jnp.einsum('bqgrd,bqgkd->bqgrk', qb, ksel).astype(jnp.float32) * scale
        smask = (kpos <= t[None, :, None, None])[:, :, :, None, :]
        ps = jax.nn.softmax(jnp.where(smask, ss_, NEG), axis=-1)
        o_s = jnp.einsum('bqgrk,bqgkd->bqgrd', ps.astype(vsel.dtype), vsel)
        kwb = lax.dynamic_slice_in_dim(kw, start, Q_BLOCK + WIN, axis=1)
        vwb = lax.dynamic_slice_in_dim(vw, start, Q_BLOCK + WIN, axis=1)
        kp = start - WIN + jnp.arange(Q_BLOCK + WIN)
        wmask = (kp[None, :] <= t[:, None]) & (kp[None, :] > t[:, None] - WIN) & (kp[None, :] >= 0)
        sw = jnp.einsum('bqgrd,bkgd->bqgrk', qb, kwb).astype(jnp.float32) * scale
        pw = jax.nn.softmax(jnp.where(wmask[None, :, None, None, :], sw, NEG), axis=-1)
        o_w = jnp.einsum('bqgrk,bkgd->bqgrd', pw.astype(vwb.dtype), vwb)
        return o_c, o_s, o_w

    o_c, o_s, o_w = lax.map(block, jnp.arange(s // Q_BLOCK))

    def unblock(o):
        return o.transpose(1, 0, 2, 3, 4, 5).reshape(b, s, NSA_HEADS, dk)

    gt = jax.nn.sigmoid(gates.reshape(b, s, NSA_HEADS, 3))
    o = gt[..., 0:1] * unblock(o_c) + gt[..., 1:2] * unblock(o_s) + gt[..., 2:3] * unblock(o_w)
    return o.reshape(b, s, NSA_WIDTH)


def pool_mixer(p, w_pool, scale):
    b, s, c = p.shape
    maxw = max(POOL_WINDOWS)
    cs = jnp.pad(jnp.cumsum(p.astype(jnp.float32), axis=1), ((0, 0), (maxw, 0), (0, 0)))
    cnt = jnp.arange(1, s + 1).astype(jnp.float32)
    groups = []
    for gi, w in enumerate(POOL_WINDOWS):
        c0, c1 = gi * POOL_GROUP_DIM, (gi + 1) * POOL_GROUP_DIM
        wsum = cs[:, maxw:, c0:c1] - cs[:, maxw - w:maxw - w + s, c0:c1]
        groups.append(wsum / jnp.minimum(cnt, float(w))[None, :, None])
    pooled = jnp.concatenate(groups, axis=-1).astype(p.dtype) - p
    y = jnp.einsum('bsgc,gcd->bsgd', pooled.reshape(b, s, POOL_GROUPS, POOL_GROUP_DIM), w_pool)
    return y.reshape(b, s, c) * scale


def spatial_gating(z, norm_g, w_s, b_s):
    b, s, _ = z.shape
    z = jax.nn.gelu(z, approximate=False)
    u, v = jnp.split(z, 2, axis=-1)
    v = rms_norm(v, norm_g).reshape(b, s // SGU_CHUNK, SGU_CHUNK, SGU_GROUPS, SGU_GROUP_DIM)
    w = w_s * jnp.tril(jnp.ones((SGU_CHUNK, SGU_CHUNK), w_s.dtype))
    mixed = jnp.einsum('gts,bnsgc->bntgc', w, v) + b_s.T[None, None, :, :, None]
    return u * mixed.reshape(b, s, SGU_WIDTH)


def setup_inputs(seed: int = 0) -> dict:
    key = jax.random.key(seed)
    k = jax.random.split(key, 20)
    f32 = jnp.float32
    nrm = lambda kk, shape: jax.random.normal(kk, shape, f32)
    L = DEPTH
    return {
        'x': nrm(k[0], (BATCH, SEQ, D_MODEL)),
        'norm1_g': 1.0 + 0.1 * nrm(k[1], (L, D_MODEL)),
        'w_in': nrm(k[2], (L, D_MODEL, N_IN)) * D_MODEL ** -0.5,
        'conv_a_w': nrm(k[3], (L, CONV_K, CONV_WIDTH_A)) * CONV_K ** -0.5,
        'qk_norm_g': 1.0 + 0.1 * nrm(k[4], (L, 4, HEAD_DIM)),
        'cmp_pe': 0.5 * nrm(k[5], (L, 2, CMP_BLOCK, HEAD_DIM)),
        'cmp_w1': nrm(k[6], (L, 2, CMP_BLOCK * HEAD_DIM, HEAD_DIM)) * (CMP_BLOCK * HEAD_DIM) ** -0.5,
        'cmp_w2': nrm(k[7], (L, 2, HEAD_DIM, HEAD_DIM)) * HEAD_DIM ** -0.5,
        'pool_w': nrm(k[8], (L, POOL_GROUPS, POOL_GROUP_DIM, POOL_GROUP_DIM)) * POOL_GROUP_DIM ** -0.5,
        'pool_scale': 1.0 + 0.1 * nrm(k[9], (L, POOL_WIDTH)),
        'sgu_norm_g': 1.0 + 0.1 * nrm(k[10], (L, SGU_WIDTH)),
        'sgu_w': nrm(k[11], (L, SGU_GROUPS, SGU_CHUNK, SGU_CHUNK)) * SGU_CHUNK ** -0.5,
        'sgu_b': 1.0 + 0.1 * nrm(k[12], (L, SGU_GROUPS, SGU_CHUNK)),
        'w_branch': nrm(k[13], (L, N_BRANCH, BRANCH_WIDTH, D_MODEL)) * BRANCH_WIDTH ** -0.5,
        'w_o': nrm(k[14], (L, D_MODEL, D_MODEL)) * D_MODEL ** -0.5,
        'norm2_g': 1.0 + 0.1 * nrm(k[15], (L, D_MODEL)),
        'w_up': nrm(k[16], (L, D_MODEL, 2 * D_FF)) * D_MODEL ** -0.5,
        'conv_ff_w': nrm(k[17], (L, FF_CONV_K, D_FF)) * FF_CONV_K ** -0.5,
        'w_down': nrm(k[18], (L, D_FF, D_MODEL)) * D_FF ** -0.5,
    }


def reference(x, norm1_g, w_in, conv_a_w, qk_norm_g, cmp_pe, cmp_w1, cmp_w2, pool_w, pool_scale,
              sgu_norm_g, sgu_w, sgu_b, w_branch, w_o, norm2_g, w_up, conv_ff_w, w_down):
    b, s, d = x.shape
    for l in range(DEPTH):
        h = rms_norm(x, norm1_g[l])
        a_b, a_c, a_x, q, kv, nsa_g, pool_in, sgu_in, merge_g = split_columns(h @ w_in[l])
        out_a = a_b * causal_dwconv(a_c * a_x, conv_a_w[l])
        out_b = nsa_mixer(q, kv, nsa_g, qk_norm_g[l], cmp_pe[l], cmp_w1[l], cmp_w2[l])
        out_c = pool_mixer(pool_in, pool_w[l], pool_scale[l])
        out_d = spatial_gating(sgu_in, sgu_norm_g[l], sgu_w[l], sgu_b[l])
        gm = jax.nn.sigmoid(merge_g.reshape(b, s, N_BRANCH, d))
        merged = (gm[:, :, 0] * (out_a @ w_branch[l, 0]) + gm[:, :, 1] * (out_b @ w_branch[l, 1])
                  + gm[:, :, 2] * (out_c @ w_branch[l, 2]) + gm[:, :, 3] * (out_d @ w_branch[l, 3]))
        x = x + merged @ w_o[l]
        h2 = rms_norm(x, norm2_g[l])
        gate, up = jnp.split(h2 @ w_up[l], 2, axis=-1)
        x = x + (jax.nn.silu(causal_dwconv(gate, conv_ff_w[l])) * up) @ w_down[l]
    return x
```

```cpp
#include <hip/hip_runtime.h>
#include <hip/hip_cooperative_groups.h>
#include <cstdio>
#include <cstdint>
#include <cmath>
namespace cg = cooperative_groups;
namespace pg8 {
#define PG8_LAS __attribute__((address_space(3)))
typedef unsigned short bf16_t;
typedef short bf16x8 __attribute__((ext_vector_type(8)));
typedef float f32x4 __attribute__((ext_vector_type(4)));
typedef unsigned u32x4 __attribute__((ext_vector_type(4)));
constexpr int BM = 256, BK = 64, HALF = 128, HTB = HALF * BK * 2  , STAGE_BYTES = 8 * HTB, NXCD = 8, WGM = 8;

__host__ __device__ __forceinline__ int lds_byte(int r, int c) { const int st = (r >> 4) * 2 + (c >> 5), rr = r & 15, cc = c & 31, ob = rr * 64 + cc * 2; return st * 1024 + (ob ^ (((ob >> 9) & 1) << 5)); }
__host__ __device__ __forceinline__ void stage_rc(int b, int& R, int& C) { const int st = b / 1024, sb = b % 1024, swz = sb ^ (((sb >> 9) & 1) << 5); R = (st >> 1) * 16 + swz / 64; C = (st & 1) * 32 + (swz % 64) / 2; }
__host__ __device__ __forceinline__ int perm32(int rho) { const int n = rho >> 4, i = rho & 15; return 8 * (i >> 2) + 4 * n + (i & 3); }

struct Unit { int pm, pn; };
struct Gemm { const bf16_t* A; const bf16_t* Bt; int M, N, K, lda, agshift; size_t agstride; };

struct StaticOrder {
    int nM, nN, nwg, G, c;
    __host__ __device__ void init(int M, int N, int G_, int c_) { nM = M / BM; nN = N / BM; nwg = nM * nN; G = G_; c = c_; }
    __host__ __device__ bool next(int i, Unit& u) const {
        const long L = (long)i * G + c; if (L >= nwg) return false;
        int wgid = (int)L; { const int q = nwg / NXCD, r = nwg % NXCD, xcd = wgid % NXCD, off = wgid / NXCD; wgid = (xcd < r ? xcd * (q + 1) : r * (q + 1) + (xcd - r) * q) + off; }
        const int nig = WGM * nN, gid = wgid / nig, fm = gid * WGM, gsz = (nM - fm) < WGM ? (nM - fm) : WGM;
        u.pm = fm + ((wgid % nig) % gsz); u.pn = (wgid % nig) / gsz; return true;
    }
    __device__ __forceinline__ void a_ready(const Unit&) const {}
    __device__ __forceinline__ void done(const Unit&) const {}
};


template <class Epi, class Sched, bool ALIGN_EPI = false, bool SP2 = false>
__device__ __forceinline__ void gemm_phase(PG8_LAS unsigned char* lds, const Gemm g, const Sched& S, const Epi& E) {
    int tid_ = threadIdx.x; asm volatile("" : "+v"(tid_));
    const int tid = tid_, wid = __builtin_amdgcn_readfirstlane(tid >> 6), lane = tid & 63, wr = wid >> 2, wc = wid & 3, fr = lane & 15, fq = lane >> 4;
    const int K = g.K, nt = K / BK;
    unsigned voffA[2], voffB[2];
#pragma unroll
    for (int i = 0; i < 2; ++i) { int R, C; stage_rc(tid * 16 + i * 8192, R, C); const int Rb = Epi::PERM ? ((R & ~31) + perm32(R & 31)) : R;
        voffA[i] = (unsigned)(R * g.lda + C) * 2u; voffB[i] = (unsigned)(Rb * K + C) * 2u; }
    const size_t kstep = (size_t)(BK * 2);
    const size_t hstepB = (size_t)HALF * K * 2; const size_t hstepA = (size_t)HALF * g.lda * 2;
    const size_t tstepB = 2 * hstepB; const size_t tstepA = 2 * hstepA;
    const unsigned ldsw = (unsigned)wid * 1024u;
    const int aoff = lds_byte(wr * 64 + fr, fq * 8), boff = lds_byte(wc * 32 + fr, fq * 8);
#define PG8_SA(b, h) (((b) * 2 + (h)) * HTB)
#define PG8_SB(b, h) ((4 + (b) * 2 + (h)) * HTB)
#define PG8_STAGE(bufoff, gbase, voff) do { _Pragma("unroll") for (int _i = 0; _i < 2; ++_i) \
        __builtin_amdgcn_global_load_lds((const unsigned*)((const char*)(gbase) + (voff)[_i]), (PG8_LAS unsigned*)(lds + (bufoff) + ldsw + _i * 8192), 16, 0, 0); } while (0)
#define PG8_LDA(dst, b, h) do { _Pragma("unroll") for (int m = 0; m < 4; ++m) _Pragma("unroll") for (int k = 0; k < 2; ++k) dst[m][k] = *(const PG8_LAS bf16x8*)(lds + PG8_SA(b, h) + aoff + m * 2048 + k * 1024); } while (0)
#define PG8_LDB(dst, b, h) do { _Pragma("unroll") for (int n = 0; n < 2; ++n) _Pragma("unroll") for (int k = 0; k < 2; ++k) dst[n][k] = *(const PG8_LAS bf16x8*)(lds + PG8_SB(b, h) + boff + n * 2048 + k * 1024); } while (0)
#define PG8_MMA(ai, bj, At, Bt) do { __builtin_amdgcn_s_setprio(1); _Pragma("unroll") for (int m = 0; m < 4; ++m) _Pragma("unroll") for (int n = 0; n < 2; ++n) _Pragma("unroll") for (int k = 0; k < 2; ++k) \
        acc[ai][bj][m][n] = __builtin_amdgcn_mfma_f32_16x16x32_bf16(Bt[n][k], At[m][k], acc[ai][bj][m][n], 0, 0, 0); __builtin_amdgcn_s_setprio(0); } while (0)
#define PG8_WAIT_V(n) asm volatile("s_waitcnt vmcnt(" #n ")" ::: "memory")
#define PG8_WAIT_L(n) asm volatile("s_waitcnt lgkmcnt(" #n ")" ::: "memory")
#define PG8_BAR __builtin_amdgcn_s_barrier()
#define PG8_SCHED __builtin_amdgcn_sched_barrier(0)
    Unit cur, nxt; int ui = 0;
    if (!S.next(0, cur)) return;
    f32x4 acc[2][2][4][2];
#pragma unroll
    for (int a = 0; a < 2; ++a)
#pragma unroll
        for (int b = 0; b < 2; ++b)
#pragma unroll
            for (int m = 0; m < 4; ++m)
#pragma unroll
                for (int n = 0; n < 2; ++n) acc[a][b][m][n] = (f32x4){0.f, 0.f, 0.f, 0.f};
    bf16x8 At[4][2], B0[2][2], B1[2][2];
    const char* cA = (const char*)g.A + (size_t)cur.pm * tstepA + (size_t)(cur.pn >> g.agshift) * g.agstride; const char* cB = (const char*)g.Bt + (size_t)cur.pn * tstepB;
    S.a_ready(cur);
    if constexpr (SP2) {
        PG8_STAGE(PG8_SB(0, 0), cB, voffB); PG8_STAGE(PG8_SB(0, 1), cB + hstepB, voffB); PG8_STAGE(PG8_SA(0, 0), cA, voffA); PG8_STAGE(PG8_SA(0, 1), cA + hstepA, voffA);
        if (wr == 1) PG8_BAR;
        PG8_WAIT_V(2); PG8_BAR;
        PG8_STAGE(PG8_SB(1, 0), cB + kstep, voffB); PG8_STAGE(PG8_SA(1, 0), cA + kstep, voffA); PG8_STAGE(PG8_SB(1, 1), cB + hstepB + kstep, voffB);
        PG8_WAIT_V(6); PG8_BAR;
    } else {
        PG8_STAGE(PG8_SB(0, 0), cB, voffB); PG8_STAGE(PG8_SA(0, 0), cA, voffA); PG8_STAGE(PG8_SB(0, 1), cB + hstepB, voffB); PG8_STAGE(PG8_SA(0, 1), cA + hstepA, voffA);
        if (wr == 1) PG8_BAR;
        PG8_WAIT_V(4); PG8_BAR;
        PG8_STAGE(PG8_SB(1, 0), cB + kstep, voffB); PG8_STAGE(PG8_SA(1, 0), cA + kstep, voffA); PG8_STAGE(PG8_SB(1, 1), cB + hstepB + kstep, voffB);
        PG8_WAIT_V(6); PG8_BAR;
    }
    for (;;) {
        const bool has_next = S.next(ui + 1, nxt);
        const char* nA = has_next ? (const char*)g.A + (size_t)nxt.pm * tstepA + (size_t)(nxt.pn >> g.agshift) * g.agstride : cA; const char* nB = has_next ? (const char*)g.Bt + (size_t)nxt.pn * tstepB : cB;
        for (int t = 0; t < nt; t += 2) {
            const bool last = (t == nt - 2);
            const char* a1 = cA + (size_t)(t + 1) * kstep;
            const char* a2 = last ? nA : cA + (size_t)(t + 2) * kstep; const char* b2 = last ? nB : cB + (size_t)(t + 2) * kstep;
            const char* a3 = a2 + kstep; const char* b3 = b2 + kstep;
            if (last && has_next) S.a_ready(nxt);
            if constexpr (SP2) {
            PG8_LDB(B0, 0, 0); PG8_LDB(B1, 0, 1); PG8_SCHED; PG8_LDA(At, 0, 0); PG8_STAGE(PG8_SA(1, 1), a1 + hstepA, voffA);
            PG8_WAIT_V(8); PG8_WAIT_L(0); PG8_BAR; PG8_MMA(0, 0, At, B0); PG8_MMA(0, 1, At, B1); PG8_BAR; PG8_SCHED;
            PG8_LDA(At, 0, 1); PG8_STAGE(PG8_SB(0, 0), b2, voffB); PG8_STAGE(PG8_SB(0, 1), b2 + hstepB, voffB); PG8_STAGE(PG8_SA(0, 0), a2, voffA);
            PG8_WAIT_V(8); PG8_WAIT_L(0); PG8_BAR; PG8_MMA(1, 0, At, B0); PG8_MMA(1, 1, At, B1); PG8_BAR; PG8_SCHED;
            PG8_LDB(B0, 1, 0); PG8_LDB(B1, 1, 1); PG8_SCHED; PG8_LDA(At, 1, 0); PG8_STAGE(PG8_SA(0, 1), a2 + hstepA, voffA);
            PG8_WAIT_V(8); PG8_WAIT_L(0); PG8_BAR; PG8_MMA(0, 0, At, B0); PG8_MMA(0, 1, At, B1); PG8_BAR; PG8_SCHED;
            PG8_LDA(At, 1, 1); PG8_STAGE(PG8_SB(1, 0), b3, voffB); PG8_STAGE(PG8_SB(1, 1), b3 + hstepB, voffB); PG8_STAGE(PG8_SA(1, 0), a3, voffA);
            PG8_WAIT_V(8); PG8_WAIT_L(0); PG8_BAR; PG8_MMA(1, 0, At, B0); PG8_MMA(1, 1, At, B1); PG8_BAR; PG8_SCHED;
            } else {
            PG8_LDB(B0, 0, 0); PG8_SCHED; PG8_LDA(At, 0, 0); PG8_STAGE(PG8_SA(1, 1), a1 + hstepA, voffA);
            PG8_WAIT_L(8); PG8_BAR; PG8_WAIT_L(0); PG8_MMA(0, 0, At, B0); PG8_BAR; PG8_SCHED;
            PG8_LDB(B1, 0, 1); PG8_STAGE(PG8_SB(0, 0), b2, voffB);
            PG8_BAR; PG8_WAIT_L(0); PG8_MMA(0, 1, At, B1); PG8_BAR;
            PG8_LDA(At, 0, 1); PG8_STAGE(PG8_SA(0, 0), a2, voffA);
            PG8_BAR; PG8_WAIT_L(0); PG8_MMA(1, 0, At, B0); PG8_BAR; PG8_SCHED;
            PG8_STAGE(PG8_SB(0, 1), b2 + hstepB, voffB);
            PG8_WAIT_V(6); PG8_BAR; PG8_MMA(1, 1, At, B1); PG8_BAR;
            PG8_LDB(B0, 1, 0); PG8_SCHED; PG8_LDA(At, 1, 0); PG8_STAGE(PG8_SA(0, 1), a2 + hstepA, voffA);
            PG8_WAIT_L(8); PG8_BAR; PG8_WAIT_L(0); PG8_MMA(0, 0, At, B0); PG8_BAR; PG8_SCHED;
            PG8_LDB(B1, 1, 1); PG8_STAGE(PG8_SB(1, 0), b3, voffB);
            PG8_BAR; PG8_WAIT_L(0); PG8_MMA(0, 1, At, B1); PG8_BAR;
            PG8_LDA(At, 1, 1); PG8_STAGE(PG8_SA(1, 0), a3, voffA);
            PG8_BAR; PG8_WAIT_L(0); PG8_MMA(1, 0, At, B0); PG8_BAR; PG8_SCHED;
            PG8_STAGE(PG8_SB(1, 1), b3 + hstepB, voffB);
            PG8_WAIT_V(6); PG8_BAR; PG8_MMA(1, 1, At, B1); PG8_BAR;
            }
        }
        if constexpr (ALIGN_EPI) { if (wr == 0) PG8_BAR; }
        if constexpr (!Epi::AFTER_DRAIN) { E(acc, cur, wr, wc, fr, fq); S.done(cur); }
        if (!has_next) break;
#pragma unroll
        for (int a = 0; a < 2; ++a)
#pragma unroll
            for (int b = 0; b < 2; ++b)
#pragma unroll
                for (int m = 0; m < 4; ++m)
#pragma unroll
                    for (int n = 0; n < 2; ++n) acc[a][b][m][n] = (f32x4){0.f, 0.f, 0.f, 0.f};
        cur = nxt; cA = nA; cB = nB; ++ui;
        if constexpr (ALIGN_EPI) { if (wr == 1) PG8_BAR; }
    }
    PG8_WAIT_V(0);
    if constexpr (!ALIGN_EPI) { if (wr == 0) PG8_BAR; }
    PG8_BAR;
    if constexpr (Epi::AFTER_DRAIN) { E.fused(acc, cur, wr, wc, fr, fq, lds, wid, lane); S.done(cur); }
#undef PG8_SA
#undef PG8_SB
#undef PG8_STAGE
#undef PG8_LDA
#undef PG8_LDB
#undef PG8_MMA
#undef PG8_WAIT_V
#undef PG8_WAIT_L
#undef PG8_BAR
#undef PG8_SCHED
}
}
namespace pg8 {
__device__ __forceinline__ unsigned cvt_pk_bf16(float lo, float hi) { typedef float f2 __attribute__((ext_vector_type(2))); typedef __bf16 b2 __attribute__((ext_vector_type(2))); f2 v = {lo, hi}; b2 b = __builtin_convertvector(v, b2); return __builtin_bit_cast(unsigned, b); }
__device__ __forceinline__ float bf_lo(unsigned w) { return __uint_as_float(w << 16); }
__device__ __forceinline__ float bf_hi(unsigned w) { return __uint_as_float(w & 0xffff0000u); }
template <int SIG> struct EpiScale {
    static constexpr bool PERM = true, AFTER_DRAIN = false;
    bf16_t* O; int ldc; int ncols; const float* ss;
    __device__ __forceinline__ void operator()(f32x4 (&acc)[2][2][4][2], const Unit& u, int wr, int wc, int fr, int fq) const {
        const int row0 = u.pm * BM + wr * 64 + fr; const int col0 = u.pn * BM + wc * 32 + 8 * fq;
        float rs[2][4];
        if (ss) { f32x4 pv[2][4];
#pragma unroll
            for (int ai = 0; ai < 2; ++ai)
#pragma unroll
                for (int m = 0; m < 4; ++m) pv[ai][m] = *(const f32x4*)(ss + (size_t)(row0 + ai * HALF + m * 16) * 16 + 4 * fq);
#pragma unroll
            for (int ai = 0; ai < 2; ++ai)
#pragma unroll
                for (int m = 0; m < 4; ++m) { float sq = (pv[ai][m][0] + pv[ai][m][1]) + (pv[ai][m][2] + pv[ai][m][3]); sq += __shfl_xor(sq, 16); sq += __shfl_xor(sq, 32); rs[ai][m] = rsqrtf(sq * (1.0f / 1024.0f) + 1e-6f); } }
        else {
#pragma unroll
            for (int ai = 0; ai < 2; ++ai)
#pragma unroll
                for (int m = 0; m < 4; ++m) rs[ai][m] = 1.0f; }
#pragma unroll
        for (int ai = 0; ai < 2; ++ai)
#pragma unroll
            for (int m = 0; m < 4; ++m) { const int row = row0 + ai * HALF + m * 16; bf16_t* rowp = O + (size_t)row * ldc;
#pragma unroll
                for (int bj = 0; bj < 2; ++bj) { const int col = col0 + bj * HALF; f32x4 v0 = acc[ai][bj][m][0] * rs[ai][m], v1 = acc[ai][bj][m][1] * rs[ai][m];
                    if (SIG) {
#pragma unroll
                        for (int e = 0; e < 4; ++e) { v0[e] = 1.0f / (1.0f + __expf(-v0[e])); v1[e] = 1.0f / (1.0f + __expf(-v1[e])); } }
                    u32x4 w; w.x = cvt_pk_bf16(v0[0], v0[1]); w.y = cvt_pk_bf16(v0[2], v0[3]); w.z = cvt_pk_bf16(v1[0], v1[1]); w.w = cvt_pk_bf16(v1[2], v1[3]);
                    if (col < ncols) *(u32x4*)(rowp + col) = w; } }
    }
};
struct EpiMerge {
    static constexpr bool PERM = true, AFTER_DRAIN = false;
    bf16_t* O; const bf16_t* P; const float* ss;
    __device__ __forceinline__ void operator()(f32x4 (&acc)[2][2][4][2], const Unit& u, int wr, int wc, int fr, int fq) const {
        typedef unsigned u32x2_ __attribute__((ext_vector_type(2)));
        const int row0 = u.pm * BM + wr * 64 + fr; const int c0 = u.pn * 64 + wc * 16 + 4 * fq;
#pragma unroll
        for (int ai = 0; ai < 2; ++ai) { f32x4 pv[4]; u32x2_ pw[4][4];
#pragma unroll
            for (int m = 0; m < 4; ++m) { const int row = row0 + ai * HALF + m * 16; pv[m] = *(const f32x4*)(ss + (size_t)row * 16 + 4 * fq); const bf16_t* prow = P + (size_t)row * 4096 + c0;
#pragma unroll
                for (int i = 0; i < 4; ++i) pw[m][i] = *(const u32x2_*)(prow + i * 1024); }
#pragma unroll
            for (int m = 0; m < 4; ++m) { const int row = row0 + ai * HALF + m * 16; float sq = (pv[m][0] + pv[m][1]) + (pv[m][2] + pv[m][3]); sq += __shfl_xor(sq, 16); sq += __shfl_xor(sq, 32); const float rs = rsqrtf(sq * (1.0f / 1024.0f) + 1e-6f);
                f32x4 tot = (f32x4){0.f, 0.f, 0.f, 0.f};
#pragma unroll
                for (int bj = 0; bj < 2; ++bj)
#pragma unroll
                    for (int n = 0; n < 2; ++n) { const u32x2_ pq = pw[m][2 * bj + n]; const f32x4 a4 = acc[ai][bj][m][n] * rs; f32x4 gsig;
#pragma unroll
                        for (int e = 0; e < 4; ++e) gsig[e] = __builtin_amdgcn_rcpf(1.0f + __builtin_amdgcn_exp2f(-1.4426950408889634f * a4[e]));
                        tot[0] += gsig[0] * bf_lo(pq.x); tot[1] += gsig[1] * bf_hi(pq.x); tot[2] += gsig[2] * bf_lo(pq.y); tot[3] += gsig[3] * bf_hi(pq.y); }
                u32x2_ w; w.x = cvt_pk_bf16(tot[0], tot[1]); w.y = cvt_pk_bf16(tot[2], tot[3]);
                *(u32x2_*)(O + (size_t)row * 1024 + c0) = w; } }
    }
};
struct EpiRes {
    static constexpr bool PERM = true, AFTER_DRAIN = false;
    const bf16_t* loin; bf16_t* loout; bf16_t* xb; float* ss; float* fout;
    __device__ __forceinline__ void operator()(f32x4 (&acc)[2][2][4][2], const Unit& u, int wr, int wc, int fr, int fq) const {
        const int row0 = u.pm * BM + wr * 64 + fr; const int col0 = u.pn * BM + wc * 32 + 8 * fq;
#pragma unroll
        for (int am = 0; am < 4; ++am) { const int ai = am >> 1; u32x4 hh[4][2], ll[4][2];
#pragma unroll
            for (int m = 2 * (am & 1); m < 2 * (am & 1) + 2; ++m) { const size_t off = (size_t)(row0 + ai * HALF + m * 16) * 1024 + col0;
#pragma unroll
                for (int bj = 0; bj < 2; ++bj) { hh[m][bj] = *(const u32x4*)(xb + off + bj * HALF); ll[m][bj] = *(const u32x4*)(loin + off + bj * HALF); } }
#pragma unroll
            for (int m = 2 * (am & 1); m < 2 * (am & 1) + 2; ++m) { const int row = row0 + ai * HALF + m * 16; const size_t off = (size_t)row * 1024 + col0; float sq = 0.f;
#pragma unroll
                for (int bj = 0; bj < 2; ++bj) { const u32x4 h4 = hh[m][bj], l4 = ll[m][bj]; f32x4 v0, v1;
                    v0[0] = acc[ai][bj][m][0][0] + (bf_lo(h4.x) + bf_lo(l4.x)); v0[1] = acc[ai][bj][m][0][1] + (bf_hi(h4.x) + bf_hi(l4.x)); v0[2] = acc[ai][bj][m][0][2] + (bf_lo(h4.y) + bf_lo(l4.y)); v0[3] = acc[ai][bj][m][0][3] + (bf_hi(h4.y) + bf_hi(l4.y));
                    v1[0] = acc[ai][bj][m][1][0] + (bf_lo(h4.z) + bf_lo(l4.z)); v1[1] = acc[ai][bj][m][1][1] + (bf_hi(h4.z) + bf_hi(l4.z)); v1[2] = acc[ai][bj][m][1][2] + (bf_lo(h4.w) + bf_lo(l4.w)); v1[3] = acc[ai][bj][m][1][3] + (bf_hi(h4.w) + bf_hi(l4.w));
                    if (fout) { *(f32x4*)(fout + off + bj * HALF) = v0; *(f32x4*)(fout + off + bj * HALF + 4) = v1; }
                    else { u32x4 w; w.x = cvt_pk_bf16(v0[0], v0[1]); w.y = cvt_pk_bf16(v0[2], v0[3]); w.z = cvt_pk_bf16(v1[0], v1[1]); w.w = cvt_pk_bf16(v1[2], v1[3]);
                        u32x4 wl; wl.x = cvt_pk_bf16(v0[0] - bf_lo(w.x), v0[1] - bf_hi(w.x)); wl.y = cvt_pk_bf16(v0[2] - bf_lo(w.y), v0[3] - bf_hi(w.y)); wl.z = cvt_pk_bf16(v1[0] - bf_lo(w.z), v1[1] - bf_hi(w.z)); wl.w = cvt_pk_bf16(v1[2] - bf_lo(w.w), v1[3] - bf_hi(w.w));
                        *(u32x4*)(xb + off + bj * HALF) = w; *(u32x4*)(loout + off + bj * HALF) = wl;
                        sq += (v0[0] * v0[0] + v0[1] * v0[1]) + (v0[2] * v0[2] + v0[3] * v0[3]) + (v1[0] * v1[0] + v1[1] * v1[1]) + (v1[2] * v1[2] + v1[3] * v1[3]); } }
                if (!fout) { sq += __shfl_xor(sq, 16); sq += __shfl_xor(sq, 32);
                    if (fq == 0) ss[(size_t)row * 16 + u.pn * 4 + wc] = sq; } } }
    }
};
template <int CTRL> __device__ __forceinline__ float dpp_ror(float v) { return __builtin_bit_cast(float, __builtin_amdgcn_mov_dpp(__builtin_bit_cast(int, v), CTRL, 0xf, 0xf, false)); }
struct EpiAct {
    bf16_t* O; const float* ss; const float* cw; float* sb; PG8_LAS float* xl;
    __device__ __forceinline__ void operator()(f32x4 (&acc)[2][2][4][2], const Unit& u, int wr, int wc, int fr_in, int fq_in) const {
        int fr = fr_in, fq = fq_in; asm volatile("" : "+v"(fr), "+v"(fq));
        const int lane = fq * 16 + fr, wave = wr * 4 + wc; const int row0 = u.pm * BM + wr * 64 + fr; const int cb = u.pn * 128 + wc * 32 + 8 * fq;
#pragma unroll
        for (int ai = 0; ai < 2; ++ai)
#pragma unroll
            for (int m = 0; m < 4; ++m) { const int row = row0 + ai * HALF + m * 16; const f32x4 pv = *(const f32x4*)(ss + (size_t)row * 16 + 4 * fq); float sq = (pv[0] + pv[1]) + (pv[2] + pv[3]); sq += __shfl_xor(sq, 16); sq += __shfl_xor(sq, 32); const float rs = rsqrtf(sq * (1.0f / 1024.0f) + 1e-6f);
#pragma unroll
                for (int bj = 0; bj < 2; ++bj)
#pragma unroll
                    for (int n = 0; n < 2; ++n) acc[ai][bj][m][n] = acc[ai][bj][m][n] * rs; }
        if (fr >= 14) {
#pragma unroll
            for (int ai = 0; ai < 2; ++ai) { PG8_LAS float* x = xl + ((((wave * 2 + ai) * 2 + (fr - 14)) * 4 + fq) * 8); *(PG8_LAS f32x4*)x = acc[ai][0][3][0]; *(PG8_LAS f32x4*)(x + 4) = acc[ai][0][3][1]; }
            if (wr == 1) { float* s = sb + ((size_t)(0 * 128 + u.pm) * 2 + (fr - 14)) * 2816 + cb; *(f32x4*)s = acc[1][0][3][0]; *(f32x4*)(s + 4) = acc[1][0][3][1]; } }
        if (wr == 0 && fr < 2) { float* s = sb + ((size_t)(1 * 128 + u.pm) * 2 + fr) * 2816 + cb; *(f32x4*)s = acc[0][0][0][0]; *(f32x4*)(s + 4) = acc[0][0][0][1];
            float* t = sb + ((size_t)(2 * 128 + u.pm) * 2 + fr) * 2816 + cb; *(f32x4*)t = acc[0][1][0][0]; *(f32x4*)(t + 4) = acc[0][1][0][1]; }
        asm volatile("s_waitcnt lgkmcnt(0)" ::: "memory"); __builtin_amdgcn_s_barrier(); asm volatile("" ::: "memory");
#pragma unroll
        for (int ai = 0; ai < 2; ++ai)
#pragma unroll
            for (int m = 0; m < 4; ++m) {
                const bool skip = (ai == 0) && (m == 0) && (wr == 0) && (fr < 2);
                bf16_t* op = O + (size_t)(row0 + ai * HALF + m * 16) * 2816 + cb;
#pragma unroll
                for (int n = 0; n < 2; ++n) { f32x4 p1, p2;
                    if (m == 0) { const int sai = (wr == 1) ? ai : (ai > 0 ? ai - 1 : 0); const int swave = (wr ^ 1) * 4 + wc;
                        p1 = *(const PG8_LAS f32x4*)(xl + ((((swave * 2 + sai) * 2 + 1) * 4 + fq) * 8) + 4 * n); p2 = *(const PG8_LAS f32x4*)(xl + ((((swave * 2 + sai) * 2 + (fr == 0 ? 0 : 1)) * 4 + fq) * 8) + 4 * n); }
#pragma unroll
                    for (int e = 0; e < 4; ++e) { const float gv = acc[ai][0][m][n][e]; const float s1 = dpp_ror<0x121>(gv), s2 = dpp_ror<0x122>(gv); float q1, q2;
                        if (m > 0) { const float pvv = acc[ai][0][m > 0 ? m - 1 : 0][n][e]; q1 = dpp_ror<0x121>(pvv); q2 = dpp_ror<0x122>(pvv); } else { q1 = p1[e]; q2 = p2[e]; }
                        p1[e] = fr >= 1 ? s1 : q1; p2[e] = fr >= 2 ? s2 : q2; }
                    const f32x4 w0 = *(const f32x4*)(cw + cb + 4 * n), w1 = *(const f32x4*)(cw + 2816 + cb + 4 * n), w2 = *(const f32x4*)(cw + 2 * 2816 + cb + 4 * n);
                    const f32x4 cv = w0 * p2 + w1 * p1 + w2 * acc[ai][0][m][n]; f32x4 o;
#pragma unroll
                    for (int e = 0; e < 4; ++e) o[e] = cv[e] * __builtin_amdgcn_rcpf(1.0f + __builtin_amdgcn_exp2f(-1.4426950408889634f * cv[e])) * acc[ai][1][m][n][e];
                    typedef unsigned u32x2_ __attribute__((ext_vector_type(2))); u32x2_ wv; wv.x = cvt_pk_bf16(o[0], o[1]); wv.y = cvt_pk_bf16(o[2], o[3]);
                    if (!skip) *(u32x2_*)(op + 4 * n) = wv;
                    asm volatile("" ::: "memory"); } }
    }
};
struct EpiAny {
    static constexpr bool PERM = true, AFTER_DRAIN = false;
    int mode;
    bf16_t* O; int ldc; int ncols; const float* ss; const float* xin; float* xout; float* ssout; PG8_LAS float* xl;
    __device__ __forceinline__ void operator()(f32x4 (&acc)[2][2][4][2], const Unit& u, int wr, int wc, int fr_in, int fq_in) const {
        int fr = fr_in, fq = fq_in; asm volatile("" : "+v"(fr), "+v"(fq));
        if (mode == 0) { EpiScale<0> e{O, ldc, ncols, ss}; e(acc, u, wr, wc, fr, fq); }
        else if (mode == 1) { EpiScale<1> e{O, ldc, ncols, ss}; e(acc, u, wr, wc, fr, fq); }
        else if (mode == 2) { EpiMerge e{O, (const bf16_t*)xin, ss}; e(acc, u, wr, wc, fr, fq); }
        else if (mode == 3) { EpiRes e{(const bf16_t*)xin, (bf16_t*)const_cast<float*>(ss), O, ssout, xout}; e(acc, u, wr, wc, fr, fq); }
        else { EpiAct e{O, ss, xin, xout, xl}; e(acc, u, wr, wc, fr, fq); }
    }
};
}
typedef unsigned short bf16_t;
typedef short bf16x8 __attribute__((ext_vector_type(8)));
typedef short s16x4 __attribute__((ext_vector_type(4)));
typedef float f32x4 __attribute__((ext_vector_type(4)));
typedef float f32x16 __attribute__((ext_vector_type(16)));
typedef unsigned u32x4 __attribute__((ext_vector_type(4)));
typedef unsigned u32x2 __attribute__((ext_vector_type(2)));
constexpr int NB = 8, SEQ = 4096, DM = 1024, MROWS = NB * SEQ, DEPTH = 4;
constexpr int NIN = 8472, ZP = 4376;
constexpr int C_AB = 0, C_AC = 512, C_AX = 1024, C_Q = 1536, C_KV = 2048, C_NG = 2816, C_PL = 2840, C_SG = 3352;
constexpr int NWIN = 8704;
constexpr int DFF = 2816, GUP = 5632;
constexpr float QSC = 0.125f * 1.4426950408889634f;
constexpr size_t MiB = 1u << 20;
constexpr size_t WS_SSA = 0;
constexpr size_t WS_KC = 2 * MiB;
constexpr size_t WS_VCT = WS_KC + 524288;
constexpr size_t WS_W1T = WS_VCT + 524288;
constexpr size_t WS_WIN = 4 * MiB;
constexpr size_t WS_WB = WS_WIN + (size_t)NWIN * 1024 * 2;
constexpr size_t WS_WO = WS_WB + (size_t)4096 * 512 * 2;
constexpr size_t WS_XB = WS_WO + (size_t)1024 * 4096 * 2;
constexpr size_t WS_VT = WS_XB + (size_t)MROWS * 1024 * 2;
constexpr size_t WS_Z1 = WS_VT + (size_t)2 * NB * 2 * 64 * SEQ * 2;
constexpr size_t WS_OUTS = WS_Z1 + (size_t)MROWS * ZP * 2;
constexpr size_t WS_END1 = WS_OUTS + (size_t)4 * MROWS * 512 * 2;
constexpr size_t WS_WDN = WS_WO + 2 * MiB;
static_assert(WS_WDN + (size_t)1024 * DFF * 2 <= WS_XB, "w_down copy fits before xb");
static_assert(WS_W1T + 524288 <= WS_WIN, "small map");
constexpr size_t WS_SSB = WS_END1;
constexpr size_t WS_WUP = WS_SSB + (size_t)MROWS * 16 * 4;
constexpr size_t WS_NEED = WS_WUP + (size_t)GUP * 1024 * 2;
constexpr size_t WS_SB = WS_OUTS + 68 * MiB;
static_assert(WS_SB + (size_t)3 * 128 * 2 * DFF * 4 <= WS_END1, "side buffers inside the outs region");
constexpr int LDS_BYTES = 147456;

struct Args { const float* in[19]; float* out; unsigned char* ws; int ph_lo, ph_hi, coop, pad; };

#define DI __device__ __forceinline__
DI unsigned cvtpk(float lo, float hi) { return pg8::cvt_pk_bf16(lo, hi); }
DI float bflo(unsigned w) { return __uint_as_float(w << 16); }
DI float bfhi(unsigned w) { return __uint_as_float(w & 0xffff0000u); }
DI float bf1(bf16_t v) { return __uint_as_float(((unsigned)v) << 16); }
DI bf16_t f2bf(float f) { return (bf16_t)(cvtpk(f, 0.f) & 0xffffu); }
DI void unpack8(const u32x4 w, float (&f)[8]) { f[0] = bflo(w.x); f[1] = bfhi(w.x); f[2] = bflo(w.y); f[3] = bfhi(w.y); f[4] = bflo(w.z); f[5] = bfhi(w.z); f[6] = bflo(w.w); f[7] = bfhi(w.w); }
DI u32x4 pack8(const float (&f)[8]) { u32x4 w; w.x = cvtpk(f[0], f[1]); w.y = cvtpk(f[2], f[3]); w.z = cvtpk(f[4], f[5]); w.w = cvtpk(f[6], f[7]); return w; }
DI float wave_sum(float v) {
#pragma unroll
    for (int o = 1; o < 64; o <<= 1) v += __shfl_xor(v, o);
    return v; }
#define LDS_FENCE() asm volatile("s_waitcnt lgkmcnt(0)" ::: "memory")

DI void tr_tile(const float* __restrict__ src, int srcN, int k0, int n0, int mode, const float* __restrict__ gk, bf16_t* dst, size_t dpitch, int ncopies, float* scr, int lane) {
    const int nn = lane & 31, n = n0 + nn; int sc = n; bool valid = true;
    if (mode == 1) { if (n >= 4608) { const int q = n - 4608, rho = q & 255; sc = ZP + (2 * (rho >> 7) + ((rho >> 2) & 1)) * 1024 + 64 * (q >> 8) + 16 * ((rho >> 5) & 3) + 4 * ((rho >> 3) & 3) + (rho & 3); } else if (n >= ZP) { sc = 0; valid = false; } }
    if (mode == 2) sc = ((n >> 7) & 1) * DFF + 128 * (n >> 8) + (n & 127);
    float v32[32];
#pragma unroll
    for (int i = 0; i < 32; ++i) { const int kk = 2 * i + (lane >> 5); v32[i] = valid ? src[(size_t)(k0 + kk) * srcN + sc] : 0.f; }
#pragma unroll
    for (int i = 0; i < 32; ++i) { const int kk = 2 * i + (lane >> 5); float v = v32[i]; if (gk) v *= gk[k0 + kk]; scr[kk * 33 + nn] = v; }
    LDS_FENCE();
    const int c = lane & 7;
#pragma unroll
    for (int j = 0; j < 4; ++j) { const int nr = (lane >> 3) + 8 * j; const float* s = scr + (8 * c) * 33 + nr; const int drow = n0 + nr;
        u32x4 o; o.x = cvtpk(s[0], s[33]); o.y = cvtpk(s[2 * 33], s[3 * 33]); o.z = cvtpk(s[4 * 33], s[5 * 33]); o.w = cvtpk(s[6 * 33], s[7 * 33]);
        const bool skip = (mode == 1) && drow >= C_PL && drow < C_PL + 512;
        if (!skip) for (int cp = 0; cp < ncopies; ++cp) *(u32x4*)(dst + (size_t)drow * dpitch + cp * 1024 + k0 + 8 * c) = o; }
    LDS_FENCE();
}
DI void pool_fold_item(const float* __restrict__ win, const float* __restrict__ pw, const float* __restrict__ psc, const float* __restrict__ g1, bf16_t* WIN, int item, int lane) {
    const int kt = item >> 4, nt = item & 15, np = nt * 32 + (lane & 31), gi = np >> 7, d = np & 127, kb = kt * 8 + (lane >> 5) * 4;
    const float* wp = pw + (size_t)gi * 128 * 128 + d; const float sc = psc[np];
    const float* wr = win + (size_t)kb * NIN + C_PL + gi * 128;
    float acc[4] = {0.f, 0.f, 0.f, 0.f};
#pragma unroll 16
    for (int c = 0; c < 128; ++c) { const float w = wp[(size_t)c * 128];
#pragma unroll
        for (int i = 0; i < 4; ++i) acc[i] += wr[(size_t)i * NIN + c] * w; }
    u32x2 o; o.x = cvtpk(acc[0] * sc * g1[kb], acc[1] * sc * g1[kb + 1]); o.y = cvtpk(acc[2] * sc * g1[kb + 2], acc[3] * sc * g1[kb + 3]);
    *(u32x2*)(WIN + (size_t)(C_PL + np) * 1024 + kb) = o;
}
DI void convert_first(const Args& a, int l, float* scr, int gw, int ngw, int lane) {
    unsigned char* ws = a.ws;
    bf16_t* WIN = (bf16_t*)(ws + WS_WIN); bf16_t* WB = (bf16_t*)(ws + WS_WB); bf16_t* WO = (bf16_t*)(ws + WS_WO); bf16_t* W1T = (bf16_t*)(ws + WS_W1T);
    const float* win = a.in[2] + (size_t)l * 1024 * NIN; const float* g1 = a.in[1] + l * 1024;
    constexpr int I_WIN = 16 * (NWIN / 32), I_PF = 2048, I_WB = 4 * 8 * 32, I_WO = 16 * 32, I_W1 = 2 * 32 * 2;
    for (int it = gw; it < I_WIN + I_PF + I_WB + I_WO + I_W1; it += ngw) {
        int r = it;
        if (r < I_WIN) { const int kt = r / (NWIN / 32), nt = r % (NWIN / 32); tr_tile(win, NIN, kt * 64, nt * 32, 1, g1, WIN, 1024, 1, scr, lane); continue; } r -= I_WIN;
        if (r < I_PF) { pool_fold_item(win, a.in[8] + (size_t)l * 4 * 128 * 128, a.in[9] + l * 512, g1, WIN, r, lane); continue; } r -= I_PF;
        if (r < I_WB) { const int i = r >> 8, rr = r & 255, kt = rr >> 5, nt = rr & 31; tr_tile(a.in[13] + ((size_t)l * 4 + i) * 512 * 1024, 1024, kt * 64, nt * 32, 0, nullptr, WB + (size_t)i * 1024 * 512, 512, 1, scr, lane); continue; } r -= I_WB;
        if (r < I_WO) { const int kt = r >> 5, nt = r & 31; tr_tile(a.in[14] + (size_t)l * 1024 * 1024, 1024, kt * 64, nt * 32, 0, nullptr, WO, 1024, 1, scr, lane); continue; } r -= I_WO;
        { const int j = r >> 6, rr = r & 63, kt = rr >> 1, nt = rr & 1; tr_tile(a.in[6] + ((size_t)l * 2 + j) * 2048 * 64, 64, kt * 64, nt * 32, 0, nullptr, W1T + (size_t)j * 64 * 2048, 2048, 1, scr, lane); }
    }
}
DI void convert_second(const Args& a, int l, float* scr, int gw, int ngw, int lane) {
    unsigned char* ws = a.ws;
    bf16_t* WUP = (bf16_t*)(ws + WS_WUP); bf16_t* WDN = (bf16_t*)(ws + WS_WDN);
    constexpr int I_UP = 16 * (GUP / 32), I_DN = (DFF / 64) * 32;
    for (int it = gw; it < I_UP + I_DN; it += ngw) {
        int r = it;
        if (r < I_UP) { const int kt = r / (GUP / 32), nt = r % (GUP / 32); tr_tile(a.in[16] + (size_t)l * 1024 * GUP, GUP, kt * 64, nt * 32, 2, a.in[15] + l * 1024, WUP, 1024, 1, scr, lane); continue; } r -= I_UP;
        { const int kt = r >> 5, nt = r & 31; tr_tile(a.in[18] + (size_t)l * DFF * 1024, 1024, kt * 64, nt * 32, 0, nullptr, WDN, DFF, 1, scr, lane); }
    }
}
DI void row_prep(const float* xrow, bf16_t* xbrow, float* ss, int lane) {
    const f32x4* xr = (const f32x4*)xrow + lane; float s = 0.f; f32x4 v[4];
#pragma unroll
    for (int j = 0; j < 4; ++j) { v[j] = xr[64 * j]; s += (v[j].x * v[j].x + v[j].y * v[j].y) + (v[j].z * v[j].z + v[j].w * v[j].w); }
    s = wave_sum(s);
    u32x2* o = (u32x2*)xbrow + lane;
#pragma unroll
    for (int j = 0; j < 4; ++j) { u32x2 w; w.x = cvtpk(v[j].x, v[j].y); w.y = cvtpk(v[j].z, v[j].w); o[64 * j] = w; }
    if (lane < 16) ss[lane] = (lane == 0) ? s : 0.f;
}

DI void mix_ac_item(const Args& a, int l, int item, int tid) {
    const bf16_t* Z1 = (const bf16_t*)(a.ws + WS_Z1); bf16_t* OA = (bf16_t*)(a.ws + WS_OUTS); bf16_t* OC = OA + (size_t)2 * MROWS * 512;
    const float* cw = a.in[3] + (size_t)l * 3 * 512;
    const int m0 = item * 64, ch = tid & 63, c0 = ch * 8, tk0 = tid >> 6;
    const u32x4 Z4 = (u32x4){0u, 0u, 0u, 0u};
    f32x4 w[3][2];
#pragma unroll
    for (int j = 0; j < 3; ++j) { w[j][0] = *(const f32x4*)(cw + j * 512 + c0); w[j][1] = *(const f32x4*)(cw + j * 512 + c0 + 4); }
    for (int b4 = 0; b4 < 2; ++b4) { u32x4 ab[4], cc[4][3], xx[4][3];
#pragma unroll
        for (int t = 0; t < 4; ++t) { const int m = m0 + tk0 + 8 * (4 * b4 + t), tt = m & (SEQ - 1); const bf16_t* zr = Z1 + (size_t)m * ZP; ab[t] = *(const u32x4*)(zr + C_AB + c0);
#pragma unroll
            for (int j = 0; j < 3; ++j) { cc[t][j] = Z4; xx[t][j] = Z4; if (tt - 2 + j >= 0) { const bf16_t* zs = zr - (size_t)(2 - j) * ZP; cc[t][j] = *(const u32x4*)(zs + C_AC + c0); xx[t][j] = *(const u32x4*)(zs + C_AX + c0); } } }
#pragma unroll
        for (int t = 0; t < 4; ++t) { const int m = m0 + tk0 + 8 * (4 * b4 + t); float abf[8], acc[8]; unpack8(ab[t], abf);
#pragma unroll
            for (int e = 0; e < 8; ++e) acc[e] = 0.f;
#pragma unroll
            for (int j = 0; j < 3; ++j) { float c_[8], x_[8]; unpack8(cc[t][j], c_); unpack8(xx[t][j], x_);
#pragma unroll
                for (int e = 0; e < 4; ++e) { acc[e] += w[j][0][e] * (c_[e] * x_[e]); acc[4 + e] += w[j][1][e] * (c_[4 + e] * x_[4 + e]); } }
#pragma unroll
            for (int e = 0; e < 8; ++e) acc[e] *= abf[e];
            *(u32x4*)(OA + (size_t)m * 512 + c0) = pack8(acc); } }
    const int gi = ch >> 4, wn = 2 << gi;
    for (int b2 = 0; b2 < 4; ++b2) { u32x4 pq[2][16];
#pragma unroll
        for (int t = 0; t < 2; ++t) { const int m = m0 + tk0 + 8 * (2 * b2 + t), tt = m & (SEQ - 1); const bf16_t* zr = Z1 + (size_t)m * ZP; const int nb = (tt + 1 < wn) ? tt + 1 : wn;
#pragma unroll
            for (int i = 0; i < 16; ++i) { pq[t][i] = Z4; if (i < nb) pq[t][i] = *(const u32x4*)(zr - (size_t)i * ZP + C_PL + c0); } }
#pragma unroll
        for (int t = 0; t < 2; ++t) { const int m = m0 + tk0 + 8 * (2 * b2 + t), tt = m & (SEQ - 1); const int nb = (tt + 1 < wn) ? tt + 1 : wn; float p0[8], sm[8]; unpack8(pq[t][0], p0);
#pragma unroll
            for (int e = 0; e < 8; ++e) sm[e] = p0[e];
#pragma unroll
            for (int i = 1; i < 16; ++i) { float q[8]; unpack8(pq[t][i], q);
#pragma unroll
                for (int e = 0; e < 8; ++e) sm[e] += q[e]; }
            const float inv = 1.0f / (float)nb;
#pragma unroll
            for (int e = 0; e < 8; ++e) sm[e] = sm[e] * inv - p0[e];
            *(u32x4*)(OC + (size_t)m * 512 + c0) = pack8(sm); } }
}
DI float gelu_erf(float v) {
    const float av = fabsf(v), t = __builtin_amdgcn_rcpf(av * 0.2316418882f + 1.0f);
    float q = t * 0.5307027145f + (-0.7265760135f); q = q * t + 0.7107068705f; q = q * t + (-0.142248368f); q = q * t + 0.127414796f; q = q * t;
    const float e = __builtin_amdgcn_exp2f((v * v) * (-0.72134752044f)); const float m = v * (q * e);
    return v < 0.f ? m : v - m;
}
DI void sgu_item(const Args& a, int l, int item, unsigned char* lds, int tid) {
    const bf16_t* Z1 = (const bf16_t*)(a.ws + WS_Z1); bf16_t* OD = (bf16_t*)(a.ws + WS_OUTS) + (size_t)3 * MROWS * 512;
    const float* ng = a.in[10] + l * 512; const float* sw = a.in[11] + (size_t)l * 4 * 128 * 128; const float* sb = a.in[12] + l * 4 * 128;
    constexpr int VP = 136;
    bf16_t* vT = (bf16_t*)lds; const int m0 = item * 128, lane = tid & 63, wave = __builtin_amdgcn_readfirstlane(tid >> 6);
    float ngv[8];
#pragma unroll
    for (int e = 0; e < 8; ++e) ngv[e] = ng[e * 64 + lane];
    for (int s4 = 0; s4 < 4; ++s4) {
        bf16_t raw[4][8];
#pragma unroll
        for (int rr = 0; rr < 4; ++rr) { const bf16_t* zr = Z1 + (size_t)(m0 + wave + 8 * (4 * s4 + rr)) * ZP + C_SG + 512 + lane;
#pragma unroll
            for (int e = 0; e < 8; ++e) raw[rr][e] = zr[e * 64]; }
#pragma unroll
        for (int rr = 0; rr < 4; ++rr) { const int s = wave + 8 * (4 * s4 + rr); float v[8]; float q = 0.f;
#pragma unroll
            for (int e = 0; e < 8; ++e) { v[e] = gelu_erf(bf1(raw[rr][e])); q += v[e] * v[e]; }
            q = wave_sum(q); const float rs = rsqrtf(q * (1.0f / 512.0f) + 1e-6f);
#pragma unroll
            for (int e = 0; e < 8; ++e) vT[(size_t)(e * 64 + lane) * VP + s] = f2bf(v[e] * rs * ngv[e]); }
    }
    __syncthreads();
    const int g = wave >> 1, hw = wave & 1, rl = lane & 31, h = lane >> 5;
    for (int q2 = 0; q2 < 2; ++q2) { const int tt = (q2 == 0) ? (hw ? 1 : 0) : (hw ? 2 : 3); const int t = 32 * tt + rl;
        f32x16 acc[4];
#pragma unroll
        for (int ct = 0; ct < 4; ++ct)
#pragma unroll
            for (int i = 0; i < 16; ++i) acc[ct][i] = 0.f;
        const float* wrow = sw + ((size_t)g * 128 + t) * 128;
        f32x4 wq[8][2];
#pragma unroll
        for (int ks = 0; ks < 8; ++ks) { const int s0 = 16 * ks + 8 * h; if (ks < 2 * (tt + 1)) { wq[ks][0] = *(const f32x4*)(wrow + s0); wq[ks][1] = *(const f32x4*)(wrow + s0 + 4); } else { wq[ks][0] = (f32x4){0.f, 0.f, 0.f, 0.f}; wq[ks][1] = (f32x4){0.f, 0.f, 0.f, 0.f}; } }
#pragma unroll
        for (int ks = 0; ks < 8; ++ks) { if (ks < 2 * (tt + 1)) { const int s0 = 16 * ks + 8 * h; f32x4 w0 = wq[ks][0], w1 = wq[ks][1];
#pragma unroll
            for (int e = 0; e < 4; ++e) { if (s0 + e > t) w0[e] = 0.f; if (s0 + 4 + e > t) w1[e] = 0.f; }
            u32x4 wp; wp.x = cvtpk(w0[0], w0[1]); wp.y = cvtpk(w0[2], w0[3]); wp.z = cvtpk(w1[0], w1[1]); wp.w = cvtpk(w1[2], w1[3]); const bf16x8 af = __builtin_bit_cast(bf16x8, wp);
#pragma unroll
            for (int ct = 0; ct < 4; ++ct) { const bf16x8 bfr = *(const bf16x8*)(vT + (size_t)(g * 128 + ct * 32 + rl) * VP + s0); acc[ct] = __builtin_amdgcn_mfma_f32_32x32x16_bf16(af, bfr, acc[ct], 0, 0, 0); } } }
#pragma unroll
        for (int ct = 0; ct < 4; ++ct) { const int c = g * 128 + ct * 32 + rl; bf16_t ur[16];
#pragma unroll
            for (int i = 0; i < 16; ++i) { const int tr = 32 * tt + (i & 3) + 8 * (i >> 2) + 4 * h; ur[i] = Z1[(size_t)(m0 + tr) * ZP + C_SG + c]; }
#pragma unroll
            for (int i = 0; i < 16; ++i) { const int tr = 32 * tt + (i & 3) + 8 * (i >> 2) + 4 * h; const float u = gelu_erf(bf1(ur[i]));
                OD[(size_t)(m0 + tr) * 512 + c] = f2bf(u * (acc[ct][i] + sb[g * 128 + tr])); } }
    }
    __syncthreads();
}
DI void prep_item(const Args& a, int l, int item, unsigned char* lds, int tid) {
    bf16_t* Z1 = (bf16_t*)(a.ws + WS_Z1); bf16_t* VT = (bf16_t*)(a.ws + WS_VT); const float* qg = a.in[4] + (size_t)l * 4 * 64;
    const int m0 = item * 64;
    { u32x4 raw[4];
#pragma unroll
      for (int it = 0; it < 4; ++it) { const int idx = tid + 512 * it, vec = idx >> 3, part = idx & 7, tok = vec >> 2, kind = (vec >> 1) & 1, g = vec & 1; raw[it] = *(const u32x4*)(Z1 + (size_t)(m0 + tok) * ZP + C_KV + (2 + 2 * kind) * 128 + g * 64 + part * 8); }
#pragma unroll
      for (int it = 0; it < 4; ++it) { const int idx = tid + 512 * it, vec = idx >> 3, part = idx & 7, tok = vec >> 2, kind = (vec >> 1) & 1, g = vec & 1;
        bf16_t* p = Z1 + (size_t)(m0 + tok) * ZP + C_KV + (2 + 2 * kind) * 128 + g * 64 + part * 8; float v[8]; unpack8(raw[it], v); float q = 0.f;
#pragma unroll
        for (int e = 0; e < 8; ++e) q += v[e] * v[e];
        q += __shfl_xor(q, 1); q += __shfl_xor(q, 2); q += __shfl_xor(q, 4); const float rs = rsqrtf(q * (1.0f / 64.0f) + 1e-6f); const float* gw = qg + (2 + kind) * 64 + part * 8;
#pragma unroll
        for (int e = 0; e < 8; ++e) v[e] = v[e] * rs * gw[e];
        *(u32x4*)p = pack8(v); } }
    bf16_t* tl = (bf16_t*)lds;
    { const int tok = tid >> 3, part = tid & 7;
#pragma unroll
      for (int t4 = 0; t4 < 4; ++t4) { const int kind = t4 >> 1, g = t4 & 1;
        *(u32x4*)(tl + t4 * 64 * 72 + tok * 72 + part * 8) = *(const u32x4*)(Z1 + (size_t)(m0 + tok) * ZP + C_KV + (3 + 2 * kind) * 128 + g * 64 + part * 8); } }
    __syncthreads();
    { const int chunk = tid & 7, d = tid >> 3, b = m0 >> 12, tt0 = m0 & (SEQ - 1);
#pragma unroll
      for (int t4 = 0; t4 < 4; ++t4) { const int kind = t4 >> 1, g = t4 & 1; const bf16_t* s = tl + t4 * 64 * 72 + (chunk * 8) * 72 + d;
        u32x4 o; o.x = (unsigned)s[0] | ((unsigned)s[72] << 16); o.y = (unsigned)s[2 * 72] | ((unsigned)s[3 * 72] << 16); o.z = (unsigned)s[4 * 72] | ((unsigned)s[5 * 72] << 16); o.w = (unsigned)s[6 * 72] | ((unsigned)s[7 * 72] << 16);
        *(u32x4*)(VT + ((((size_t)kind * NB + b) * 2 + g) * 64 + d) * SEQ + tt0 + chunk * 8) = o; } }
    __syncthreads();
}
DI void compress_item(const Args& a, int l, int item, unsigned char* lds, int tid) {
    const bf16_t* Z1 = (const bf16_t*)(a.ws + WS_Z1); bf16_t* KC = (bf16_t*)(a.ws + WS_KC); bf16_t* VCT = (bf16_t*)(a.ws + WS_VCT); const bf16_t* W1T = (const bf16_t*)(a.ws + WS_W1T);
    const int lane = tid & 63, wave = __builtin_amdgcn_readfirstlane(tid >> 6);
    const int tix = item % 17, r3 = item / 17, j = r3 & 1, g = (r3 >> 1) & 1, b = r3 >> 2;
    const float* pe = a.in[5] + ((size_t)l * 2 + j) * 2048; const float* w2 = a.in[7] + ((size_t)l * 2 + j) * 64 * 64; const float* g1 = a.in[4] + (size_t)l * 4 * 64 + 64;
    const int r = lane & 15, kq = lane >> 4, n = 15 * tix + r;
    const bf16_t* arow = Z1 + ((size_t)b * SEQ + 16 * n) * ZP + C_KV + j * 128 + g * 64;
    const bf16_t* wrow = W1T + (size_t)j * 64 * 2048 + (size_t)r * 2048;
    float* part = (float*)lds; float* hs = (float*)(lds + 32768);
    pg8::f32x4 acc[4];
#pragma unroll
    for (int ct = 0; ct < 4; ++ct) acc[ct] = (pg8::f32x4){0.f, 0.f, 0.f, 0.f};
#pragma unroll
    for (int ks = 0; ks < 8; ++ks) { const int kk = wave * 256 + ks * 32 + kq * 8, li = kk >> 6, d0 = kk & 63; bf16x8 af;
        if (r < 15) af = *(const bf16x8*)(arow + (size_t)li * ZP + d0);
        else { const f32x4 p0 = *(const f32x4*)(pe + kk), p1 = *(const f32x4*)(pe + kk + 4); u32x4 w; w.x = cvtpk(p0[0], p0[1]); w.y = cvtpk(p0[2], p0[3]); w.z = cvtpk(p1[0], p1[1]); w.w = cvtpk(p1[2], p1[3]); af = __builtin_bit_cast(bf16x8, w); }
#pragma unroll
        for (int ct = 0; ct < 4; ++ct) { const bf16x8 bfr = *(const bf16x8*)(wrow + (size_t)ct * 16 * 2048 + kk); acc[ct] = __builtin_amdgcn_mfma_f32_16x16x32_bf16(af, bfr, acc[ct], 0, 0, 0); } }
#pragma unroll
    for (int ct = 0; ct < 4; ++ct)
#pragma unroll
        for (int i = 0; i < 4; ++i) part[wave * 1024 + (4 * kq + i) * 64 + ct * 16 + r] = acc[ct][i];
    __syncthreads();
    { float s0 = 0.f, s1 = 0.f;
#pragma unroll
      for (int w = 0; w < 8; ++w) { s0 += part[w * 1024 + tid]; s1 += part[w * 1024 + 512 + tid]; }
      hs[tid] = s0; hs[512 + tid] = s1; }
    __syncthreads();
    { const float b0 = hs[15 * 64 + (tid & 63)]; const float x0 = hs[tid] + b0, x1 = hs[512 + tid] + b0;
      __syncthreads();
      hs[tid] = x0 / (1.0f + __expf(-x0)); hs[512 + tid] = x1 / (1.0f + __expf(-x1)); }
    __syncthreads();
    { const int r0 = wave, r1 = wave + 8; float o0 = 0.f, o1 = 0.f;
#pragma unroll
      for (int k16 = 0; k16 < 4; ++k16) { float wv[16];
#pragma unroll
          for (int k = 0; k < 16; ++k) wv[k] = w2[(k16 * 16 + k) * 64 + lane];
#pragma unroll
          for (int k = 0; k < 16; ++k) { o0 += hs[r0 * 64 + k16 * 16 + k] * wv[k]; o1 += hs[r1 * 64 + k16 * 16 + k] * wv[k]; } }
      if (j == 0) { const float gg = g1[lane];
          { const float q = wave_sum(o0 * o0); KC[(((size_t)b * 2 + g) * 256 + 15 * tix + r0) * 64 + lane] = f2bf(o0 * rsqrtf(q * (1.0f / 64.0f) + 1e-6f) * gg); }
          { const float q = wave_sum(o1 * o1); if (r1 < 15) KC[(((size_t)b * 2 + g) * 256 + 15 * tix + r1) * 64 + lane] = f2bf(o1 * rsqrtf(q * (1.0f / 64.0f) + 1e-6f) * gg); }
          if (tix == 16 && wave == 0) KC[(((size_t)b * 2 + g) * 256 + 255) * 64 + lane] = 0;
      } else {
          VCT[(((size_t)b * 2 + g) * 64 + lane) * 256 + 15 * tix + r0] = f2bf(o0);
          if (r1 < 15) VCT[(((size_t)b * 2 + g) * 64 + lane) * 256 + 15 * tix + r1] = f2bf(o1);
          if (tix == 16 && wave == 0) VCT[(((size_t)b * 2 + g) * 64 + lane) * 256 + 255] = 0;
      } }
    __syncthreads();
}
DI void act_fixup(const Args& a, int l, int gtid, int ngt) {
    bf16_t* ACT = (bf16_t*)(a.ws + WS_Z1); const float* sb = (const float*)(a.ws + WS_SB); const float* cw = a.in[17] + (size_t)l * 3 * DFF;
    for (int idx = gtid; idx < 128 * 2 * DFF; idx += ngt) { const int c = idx % DFF, rr = idx / DFF, r = rr & 1, pm = rr >> 1, row = pm * 256 + r, tt = row & (SEQ - 1);
        const float g0 = sb[((size_t)(1 * 128 + pm) * 2 + r) * DFF + c], up = sb[((size_t)(2 * 128 + pm) * 2 + r) * DFF + c];
        const int pmm = pm > 0 ? pm - 1 : 0;
        const float last1 = sb[((size_t)(0 * 128 + pmm) * 2 + 1) * DFF + c], last0 = sb[((size_t)(0 * 128 + pmm) * 2 + 0) * DFF + c];
        float g1, g2;
        if (r == 1) { g1 = sb[((size_t)(1 * 128 + pm) * 2 + 0) * DFF + c]; g2 = tt >= 2 ? last1 : 0.f; }
        else { g1 = tt >= 1 ? last1 : 0.f; g2 = tt >= 2 ? last0 : 0.f; }
        const float cv = cw[c] * g2 + cw[DFF + c] * g1 + cw[2 * DFF + c] * g0;
        ACT[(size_t)row * DFF + c] = f2bf(cv / (1.0f + __expf(-cv)) * up); }
}
#define MFMA32(a, b, c) __builtin_amdgcn_mfma_f32_32x32x16_bf16((a), (b), (c), 0, 0, 0)
constexpr int NRT = 1, NTOK = 8 * NRT, LPT = 64 / NTOK, CPL = 64 / LPT;
struct AttnSt { f32x16 o[2][NRT]; float l[NRT]; };
DI int crow(int i, int h) { return (i & 3) + 8 * (i >> 2) + 4 * h; }
DI void attn_reset(AttnSt& st) {
#pragma unroll
    for (int dt = 0; dt < 2; ++dt)
#pragma unroll
        for (int rt = 0; rt < NRT; ++rt)
#pragma unroll
            for (int i = 0; i < 16; ++i) st.o[dt][rt][i] = 0.f;
    for (int rt = 0; rt < NRT; ++rt) st.l[rt] = 0.f; }
struct KV { bf16x8 kf[4]; s16x4 v[2][2][2]; };
DI void kv_load(KV& f, const bf16_t* kp, const bf16_t* vp, size_t vpitch) {
#pragma unroll
    for (int dc = 0; dc < 4; ++dc) f.kf[dc] = *(const bf16x8*)(kp + dc * 16);
#pragma unroll
    for (int dt = 0; dt < 2; ++dt)
#pragma unroll
        for (int sx = 0; sx < 2; ++sx) { const bf16_t* q = vp + (size_t)dt * 32 * vpitch + 16 * sx; f.v[dt][sx][0] = *(const s16x4*)q; f.v[dt][sx][1] = *(const s16x4*)(q + 8); }
}
DI void kv_copy(KV& d, const KV& s_) {
#pragma unroll
    for (int dc = 0; dc < 4; ++dc) d.kf[dc] = s_.kf[dc];
#pragma unroll
    for (int dt = 0; dt < 2; ++dt)
#pragma unroll
        for (int sx = 0; sx < 2; ++sx) { d.v[dt][sx][0] = s_.v[dt][sx][0]; d.v[dt][sx][1] = s_.v[dt][sx][1]; }
}
DI void attn_scores(f32x16 (&s)[NRT], const bf16x8 (&qf)[NRT][4], const KV& f) {
#pragma unroll
    for (int rt = 0; rt < NRT; ++rt) { f32x16 z;
#pragma unroll
        for (int i = 0; i < 16; ++i) z[i] = 0.f;
#pragma unroll
        for (int dc = 0; dc < 4; ++dc) z = MFMA32(f.kf[dc], qf[rt][dc], z);
        s[rt] = z; }
}
DI void attn_softmax(AttnSt& st, f32x16 (&s)[NRT], float cref, bool rowon) {
#pragma unroll
    for (int rt = 0; rt < NRT; ++rt) { float ps = 0.f;
        if (cref != 0.f) {
#pragma unroll
            for (int i = 0; i < 16; ++i) s[rt][i] -= cref; }
#pragma unroll
        for (int i = 0; i < 16; ++i) { const float p = __builtin_amdgcn_exp2f(s[rt][i]); s[rt][i] = p; ps += p; }
        st.l[rt] += rowon ? ps : 0.f; }
}
DI void attn_pv(AttnSt& st, const f32x16 (&p)[NRT], const KV& f, bool rowon) {
    bf16x8 pf[NRT][2];
#pragma unroll
    for (int rt = 0; rt < NRT; ++rt)
#pragma unroll
        for (int sx = 0; sx < 2; ++sx) { u32x4 w; w.x = cvtpk(p[rt][8 * sx], p[rt][8 * sx + 1]); w.y = cvtpk(p[rt][8 * sx + 2], p[rt][8 * sx + 3]); w.z = cvtpk(p[rt][8 * sx + 4], p[rt][8 * sx + 5]); w.w = cvtpk(p[rt][8 * sx + 6], p[rt][8 * sx + 7]); if (!rowon) { w.x = 0u; w.y = 0u; w.z = 0u; w.w = 0u; } pf[rt][sx] = __builtin_bit_cast(bf16x8, w); }
#pragma unroll
    for (int dt = 0; dt < 2; ++dt)
#pragma unroll
        for (int rt = 0; rt < NRT; ++rt)
#pragma unroll
            for (int sx = 0; sx < 2; ++sx) { const bf16x8 vf = __builtin_shufflevector(f.v[dt][sx][0], f.v[dt][sx][1], 0, 1, 2, 3, 4, 5, 6, 7); st.o[dt][rt] = MFMA32(vf, pf[rt][sx], st.o[dt][rt]); }
}
template <bool FIRST> DI void attn_flush(const AttnSt& st, const float (&sc)[NRT], bf16_t* const (&orow)[NRT]) {
#pragma unroll
    for (int rt = 0; rt < NRT; ++rt) { u32x2 old[2][4];
        if (!FIRST) {
#pragma unroll
            for (int dt = 0; dt < 2; ++dt)
#pragma unroll
                for (int q4 = 0; q4 < 4; ++q4) old[dt][q4] = *(const u32x2*)(orow[rt] + dt * 32 + 8 * q4); }
#pragma unroll
        for (int dt = 0; dt < 2; ++dt)
#pragma unroll
            for (int q4 = 0; q4 < 4; ++q4) { u32x2* p = (u32x2*)(orow[rt] + dt * 32 + 8 * q4); float v0 = st.o[dt][rt][4 * q4] * sc[rt], v1 = st.o[dt][rt][4 * q4 + 1] * sc[rt], v2 = st.o[dt][rt][4 * q4 + 2] * sc[rt], v3 = st.o[dt][rt][4 * q4 + 3] * sc[rt];
                if (!FIRST) { v0 += bflo(old[dt][q4].x); v1 += bfhi(old[dt][q4].x); v2 += bflo(old[dt][q4].y); v3 += bfhi(old[dt][q4].y); }
                u32x2 w; w.x = cvtpk(v0, v1); w.y = cvtpk(v2, v3); *p = w; } }
}
typedef const __attribute__((address_space(3))) unsigned char* LP;
DI void kv_load_lds(KV& f, LP kp, LP vp, int vpitch_b) {
#pragma unroll
    for (int dc = 0; dc < 4; ++dc) f.kf[dc] = *(const __attribute__((address_space(3))) bf16x8*)(kp + dc * 32);
#pragma unroll
    for (int dt = 0; dt < 2; ++dt)
#pragma unroll
        for (int sx = 0; sx < 2; ++sx) { LP q = vp + dt * 32 * vpitch_b + 32 * sx; f.v[dt][sx][0] = *(const __attribute__((address_space(3))) s16x4*)q; f.v[dt][sx][1] = *(const __attribute__((address_space(3))) s16x4*)(q + 16); }
}
struct MaskCausal { int tk; DI bool operator()(int kp) const { return kp <= tk; } };
struct MaskWindow { int tk; DI bool operator()(int kp) const { return kp <= tk && kp > tk - 512; } };
template <class M> DI void attn_block64(AttnSt& st, const bf16x8 (&qf)[NRT][4], LP kt, LP vt, int kpb, int vpb, float cref, bool rowon, bool domask, const M mk, int kbase, int h) {
    KV f0, f1;
#pragma unroll
    for (int dc = 0; dc < 4; ++dc) { f0.kf[dc] = *(const __attribute__((address_space(3))) bf16x8*)(kt + dc * 32); f1.kf[dc] = *(const __attribute__((address_space(3))) bf16x8*)(kt + 32 * kpb + dc * 32); }
    f32x16 s0[NRT], s1[NRT]; attn_scores(s0, qf, f0); attn_scores(s1, qf, f1);
    __builtin_amdgcn_sched_barrier(0);
#pragma unroll
    for (int dt = 0; dt < 2; ++dt)
#pragma unroll
        for (int sx = 0; sx < 2; ++sx) { LP q = vt + dt * 32 * vpb + 32 * sx; f0.v[dt][sx][0] = *(const __attribute__((address_space(3))) s16x4*)q; f0.v[dt][sx][1] = *(const __attribute__((address_space(3))) s16x4*)(q + 16);
            f1.v[dt][sx][0] = *(const __attribute__((address_space(3))) s16x4*)(q + 64); f1.v[dt][sx][1] = *(const __attribute__((address_space(3))) s16x4*)(q + 80); }
    if (domask) {
#pragma unroll
        for (int i = 0; i < 16; ++i) { if (!mk(kbase + crow(i, h))) s0[0][i] = -INFINITY; if (!mk(kbase + 32 + crow(i, h))) s1[0][i] = -INFINITY; } }
    if (cref != 0.f) {
#pragma unroll
        for (int i = 0; i < 16; ++i) { s0[0][i] -= cref; s1[0][i] -= cref; } }
    float ps0 = 0.f, ps1 = 0.f;
#pragma unroll
    for (int i = 0; i < 16; ++i) { const float p0 = __builtin_amdgcn_exp2f(s0[0][i]); s0[0][i] = p0; ps0 += p0; }
    attn_pv(st, s0, f0, rowon);
#pragma unroll
    for (int i = 0; i < 16; ++i) { const float p1 = __builtin_amdgcn_exp2f(s1[0][i]); s1[0][i] = p1; ps1 += p1; }
    st.l[0] += rowon ? (ps0 + ps1) : 0.f;
    attn_pv(st, s1, f1, rowon);
}
constexpr int AL_KC = 0, KC_PB = 144, AL_VC = 36864, VC_PB = 520, AL_KR = AL_VC + 64 * VC_PB, KR_PB = 144, KR_SZ = 64 * KR_PB, AL_VR = AL_KR + 2 * KR_SZ, VR_PB = 136, VR_SZ = 64 * VR_PB, AL_WT = AL_VR + 2 * VR_SZ, WT_SZ = 4224, AL_UW = AL_WT + 8 * WT_SZ;
static_assert(AL_UW + 64 <= LDS_BYTES - 64, "attention LDS map");
DI void nsa_wg_unit(const Args& a, int l, int b, int g, int tb, unsigned char* lds, int tid_in, bool stage) {
    int tid = tid_in; asm volatile("" : "+v"(tid));
    const int lane = tid & 63, wave = __builtin_amdgcn_readfirstlane(tid >> 6);
    const bf16_t* Z1 = (const bf16_t*)(a.ws + WS_Z1);
    const bf16_t* KC = (const bf16_t*)(a.ws + WS_KC) + ((size_t)b * 2 + g) * 256 * 64; const bf16_t* VCT = (const bf16_t*)(a.ws + WS_VCT) + ((size_t)b * 2 + g) * 64 * 256;
    const bf16_t* VST = (const bf16_t*)(a.ws + WS_VT) + (((size_t)0 * NB + b) * 2 + g) * 64 * SEQ; const bf16_t* VWT = (const bf16_t*)(a.ws + WS_VT) + (((size_t)1 * NB + b) * 2 + g) * 64 * SEQ;
    bf16_t* OB = (bf16_t*)(a.ws + WS_OUTS) + (size_t)MROWS * 512;
    const int rl = lane & 31, h = lane >> 5, head = rl & 3, t0 = tb * 64 + wave * 8, jt = tb;
    int tk[NRT]; tk[0] = t0 + (rl >> 2);
    const bf16_t* zb = Z1 + (size_t)b * SEQ * ZP;
    LP L = (LP)lds;
    __syncthreads();
    if (stage) {
    for (int i = tid; i < 2048; i += 512) { const int row = i >> 3, ch = i & 7; *(u32x4*)(lds + AL_KC + row * KC_PB + ch * 16) = *(const u32x4*)(KC + row * 64 + ch * 8); }
    for (int i = tid; i < 2048; i += 512) { const int row = i >> 5, ch = i & 31; const u32x4 v = *(const u32x4*)(VCT + row * 256 + ch * 8); u32x2* d = (u32x2*)(lds + AL_VC + row * VC_PB + ch * 16); u32x2 lo, hi; lo.x = v.x; lo.y = v.y; hi.x = v.z; hi.y = v.w; d[0] = lo; d[1] = hi; }
    }
    bf16x8 qf[NRT][4]; float gt[NRT][3]; bf16_t* orow[NRT];
    { const bf16_t* zr = zb + (size_t)tk[0] * ZP;
#pragma unroll
      for (int dc = 0; dc < 4; ++dc) qf[0][dc] = *(const bf16x8*)(zr + C_Q + (g * 4 + head) * 64 + dc * 16 + 8 * h);
      { const float* qg = a.in[4] + (size_t)l * 4 * 64; float qv[4][8]; float qs = 0.f;
#pragma unroll
        for (int dc = 0; dc < 4; ++dc) { unpack8(__builtin_bit_cast(u32x4, qf[0][dc]), qv[dc]);
#pragma unroll
            for (int e = 0; e < 8; ++e) qs += qv[dc][e] * qv[dc][e]; }
        qs += __shfl_xor(qs, 32); const float rs = rsqrtf(qs * (1.0f / 64.0f) + 1e-6f) * QSC;
#pragma unroll
        for (int dc = 0; dc < 4; ++dc) { const f32x4 g0 = *(const f32x4*)(qg + dc * 16 + 8 * h), g1 = *(const f32x4*)(qg + dc * 16 + 8 * h + 4);
#pragma unroll
            for (int e = 0; e < 4; ++e) { qv[dc][e] = qv[dc][e] * rs * g0[e]; qv[dc][4 + e] = qv[dc][4 + e] * rs * g1[e]; }
            qf[0][dc] = __builtin_bit_cast(bf16x8, pack8(qv[dc])); } }
#pragma unroll
      for (int br = 0; br < 3; ++br) gt[0][br] = 1.0f / (1.0f + __expf(-bf1(zr[C_NG + (g * 4 + head) * 3 + br])));
      orow[0] = OB + ((size_t)b * SEQ + tk[0]) * 512 + (g * 4 + head) * 64 + 4 * h; }
    float cref[3];
    { const float* qg = a.in[4] + (size_t)l * 4 * 64; float mx[4];
#pragma unroll
      for (int k4 = 0; k4 < 4; ++k4) { float v = fabsf(qg[k4 * 64 + lane]);
#pragma unroll
          for (int o = 1; o < 64; o <<= 1) v = fmaxf(v, __shfl_xor(v, o));
          mx[k4] = v; }
#pragma unroll
      for (int br = 0; br < 3; ++br) { const float bnd = 64.0f * QSC * mx[0] * mx[1 + br]; cref[br] = bnd > 64.0f ? bnd : 0.f; } }
    float* wl = (float*)(lds + AL_WT + wave * WT_SZ); float* IA = wl; float* IB = wl + NTOK * 65;
    for (int i = lane; i < 2 * NTOK * 65; i += 64) wl[i] = 0.f;
    __syncthreads();
    AttnSt st;
    int nv[NRT]; nv[0] = tk[0] >= 31 ? ((tk[0] - 31) >> 4) + 1 : 0;
    const int nvmax = (t0 + NTOK - 1 >= 31) ? ((t0 + NTOK - 1 - 31) >> 4) + 1 : 0, nst = (nvmax + 31) >> 5;
    st.l[0] = 0.f;
    const LP kcl = L + AL_KC + rl * KC_PB + 16 * h, vcl = L + AL_VC + rl * VC_PB + 8 * h;
    for (int T = 0; T < nst; ++T) { f32x16 s[NRT]; KV f; kv_load_lds(f, kcl + 32 * T * KC_PB, vcl + 64 * T, VC_PB); attn_scores(s, qf, f); float ps = 0.f;
#pragma unroll
        for (int i = 0; i < 16; ++i) { const float sv = (32 * T + crow(i, h) >= nv[0]) ? -INFINITY : s[0][i] - cref[0]; ps += __builtin_amdgcn_exp2f(sv); }
        st.l[0] += ps; }
    float mu2, inv;
    { const float lt = st.l[0] + __shfl_xor(st.l[0], 32); inv = lt > 0.f ? 1.0f / lt : 0.f; mu2 = cref[0]; }
    attn_reset(st);
    for (int T = 0; T < nst; ++T) { f32x16 s[NRT]; KV f; kv_load_lds(f, kcl + 32 * T * KC_PB, vcl + 64 * T, VC_PB); attn_scores(s, qf, f);
#pragma unroll
        for (int i = 0; i < 16; ++i) { const float p = __builtin_amdgcn_exp2f(s[0][i] - mu2) * inv; s[0][i] = (32 * T + crow(i, h) >= nv[0]) ? 0.f : p; }
#pragma unroll
        for (int q4 = 0; q4 < 4; ++q4) { float p3 = 0.5f * s[0][4 * q4 + 3]; float av = (s[0][4 * q4] + s[0][4 * q4 + 1]) + (s[0][4 * q4 + 2] + p3);
            av += __shfl_xor(av, 1); av += __shfl_xor(av, 2); p3 += __shfl_xor(p3, 1); p3 += __shfl_xor(p3, 2);
            if (head == 0) { const int j = 8 * T + 2 * q4 + h, tok16 = (rl >> 2); IA[tok16 * 65 + j] = av; if (j + 1 < 64) IB[tok16 * 65 + j + 1] = p3; } }
        attn_pv(st, s, f, true); }
    { float sc[NRT]; sc[0] = gt[0][0]; attn_flush<true>(st, sc, orow); }
    LDS_FENCE();
    unsigned sel_lo[NRT], sel_hi[NRT], ulo, uhi;
    { const int tok = lane / LPT, qtr = lane % LPT; float mv[CPL];
#pragma unroll
      for (int c = 0; c < CPL; ++c) { const int j = qtr * CPL + c; float v = IA[tok * 65 + j] + IB[tok * 65 + j]; const bool forced = (j == 0) | (j == jt) | (j == jt - 1); v = forced ? 1e6f : (j > jt ? -1e30f : v); mv[c] = v; }
      LDS_FENCE();
#pragma unroll
      for (int c = 0; c < CPL; ++c) IA[tok * 65 + qtr * CPL + c] = mv[c];
      LDS_FENCE();
      int cnt[CPL];
#pragma unroll
      for (int c = 0; c < CPL; ++c) cnt[c] = (qtr * CPL + c <= jt) ? 0 : 64;
      if (jt >= 16)
#pragma unroll 4
      for (int i = 0; i < 64; ++i) { const float vi = IA[tok * 65 + i];
#pragma unroll
          for (int c = 0; c < CPL; ++c) { const int j = qtr * CPL + c; cnt[c] += ((vi > mv[c]) || (vi == mv[c] && i < j)) ? 1 : 0; } }
      unsigned mc = 0;
#pragma unroll
      for (int c = 0; c < CPL; ++c) mc |= (cnt[c] < 16) ? (1u << c) : 0u;
      unsigned lo = 0, hi = 0;
#pragma unroll
      for (int k = 0; k < LPT / 2; ++k) { lo |= (unsigned)__shfl((int)mc, tok * LPT + k) << (CPL * k); hi |= (unsigned)__shfl((int)mc, tok * LPT + LPT / 2 + k) << (CPL * k); }
      { const int src = (rl >> 2) * LPT; sel_lo[0] = (unsigned)__shfl((int)lo, src); sel_hi[0] = (unsigned)__shfl((int)hi, src); }
      unsigned ul = lo, uh = hi;
#pragma unroll
      for (int o = LPT; o < 64; o <<= 1) { ul |= (unsigned)__shfl_xor((int)ul, o); uh |= (unsigned)__shfl_xor((int)uh, o); }
      ulo = (unsigned)__builtin_amdgcn_readfirstlane((int)ul); uhi = (unsigned)__builtin_amdgcn_readfirstlane((int)uh); }
    const unsigned long long myu = ((unsigned long long)uhi << 32) | (unsigned long long)ulo;
    unsigned long long* UW = (unsigned long long*)(lds + AL_UW);
    if (lane == 0) UW[wave] = myu;
    __syncthreads();
    unsigned long long wgu = 0ull;
#pragma unroll
    for (int w = 0; w < 8; ++w) wgu |= UW[w];
    wgu = ((unsigned long long)(unsigned)__builtin_amdgcn_readfirstlane((int)(wgu >> 32)) << 32) | (unsigned long long)(unsigned)__builtin_amdgcn_readfirstlane((int)(unsigned)wgu);
    const int srow = tid >> 3, sch = tid & 7;
    const LP kfl = L + AL_KR + rl * KR_PB + 16 * h, vfl = L + AL_VR + rl * VR_PB + 8 * h;
    attn_reset(st);
    { unsigned long long rem = wgu & ((jt >= 63) ? ~0ull : ((1ull << (jt + 1)) - 1ull));
      const unsigned koff = (unsigned)(srow * ZP + sch * 8) * 2u, voff = (unsigned)(srow * SEQ + sch * 8) * 2u;
      const char* kgb = (const char*)(zb + C_KV + 2 * 128 + g * 64); const char* vgb = (const char*)VST;
      int j = rem ? (int)__builtin_ctzll(rem) : -1, bi = 0; u32x4 kreg, vreg;
      if (j >= 0) { kreg = *(const u32x4*)(kgb + (size_t)(64 * j) * ZP * 2 + koff); vreg = *(const u32x4*)(vgb + (size_t)(64 * j) * 2 + voff);
          *(u32x4*)(lds + AL_KR + srow * KR_PB + sch * 16) = kreg; u32x2* d = (u32x2*)(lds + AL_VR + srow * VR_PB + sch * 16); u32x2 lo2, hi2; lo2.x = vreg.x; lo2.y = vreg.y; hi2.x = vreg.z; hi2.y = vreg.w; d[0] = lo2; d[1] = hi2; }
      __syncthreads();
      while (j >= 0) {
          rem &= rem - 1ull; const int nj = rem ? (int)__builtin_ctzll(rem) : -1;
          if (nj >= 0) { kreg = *(const u32x4*)(kgb + (size_t)(64 * nj) * ZP * 2 + koff); vreg = *(const u32x4*)(vgb + (size_t)(64 * nj) * 2 + voff); }
          if ((myu >> j) & 1ull) {
              const bool on = ((j < 32) ? (sel_lo[0] >> j) & 1u : (sel_hi[0] >> (j - 32)) & 1u) != 0u;
              attn_block64(st, qf, kfl + bi * KR_SZ, vfl + bi * VR_SZ, KR_PB, VR_PB, cref[1], on, j == jt, MaskCausal{tk[0]}, 64 * j, h); }
          if (nj >= 0) { const int nb = bi ^ 1; *(u32x4*)(lds + AL_KR + nb * KR_SZ + srow * KR_PB + sch * 16) = kreg; u32x2* d = (u32x2*)(lds + AL_VR + nb * VR_SZ + srow * VR_PB + sch * 16); u32x2 lo2, hi2; lo2.x = vreg.x; lo2.y = vreg.y; hi2.x = vreg.z; hi2.y = vreg.w; d[0] = lo2; d[1] = hi2; }
          __syncthreads();
          j = nj; bi ^= 1; } }
    { float sc[NRT]; const float lt = st.l[0] + __shfl_xor(st.l[0], 32); sc[0] = lt > 0.f ? gt[0][1] / lt : 0.f; attn_flush<false>(st, sc, orow); }
    attn_reset(st);
    { const unsigned koff = (unsigned)(srow * ZP + sch * 8) * 2u, voff = (unsigned)(srow * SEQ + sch * 8) * 2u; const char* kgb = (const char*)(zb + C_KV + 4 * 128 + g * 64); const char* vgb = (const char*)VWT;
      int j = tb - 8 < 0 ? 0 : tb - 8, bi = 0; u32x4 kreg, vreg;
      { kreg = *(const u32x4*)(kgb + (size_t)(64 * j) * ZP * 2 + koff); vreg = *(const u32x4*)(vgb + (size_t)(64 * j) * 2 + voff);
        *(u32x4*)(lds + AL_KR + srow * KR_PB + sch * 16) = kreg; u32x2* d = (u32x2*)(lds + AL_VR + srow * VR_PB + sch * 16); u32x2 lo2, hi2; lo2.x = vreg.x; lo2.y = vreg.y; hi2.x = vreg.z; hi2.y = vreg.w; d[0] = lo2; d[1] = hi2; }
      __syncthreads();
      for (; j <= tb; ++j) { const bool hn = j + 1 <= tb;
          if (hn) { kreg = *(const u32x4*)(kgb + (size_t)(64 * (j + 1)) * ZP * 2 + koff); vreg = *(const u32x4*)(vgb + (size_t)(64 * (j + 1)) * 2 + voff); }
          if (64 * j + 63 >= t0 - 511 && 64 * j <= t0 + NTOK - 1)
              attn_block64(st, qf, kfl + bi * KR_SZ, vfl + bi * VR_SZ, KR_PB, VR_PB, cref[2], true, (64 * j + 63 > t0) || (64 * j <= t0 + NTOK - 1 - 512), MaskWindow{tk[0]}, 64 * j, h);
          if (hn) { const int nb = bi ^ 1; *(u32x4*)(lds + AL_KR + nb * KR_SZ + srow * KR_PB + sch * 16) = kreg; u32x2* d = (u32x2*)(lds + AL_VR + nb * VR_SZ + srow * VR_PB + sch * 16); u32x2 lo2, hi2; lo2.x = vreg.x; lo2.y = vreg.y; hi2.x = vreg.z; hi2.y = vreg.w; d[0] = lo2; d[1] = hi2; }
          __syncthreads();
          bi ^= 1; } }
    { float sc[NRT]; const float lt = st.l[0] + __shfl_xor(st.l[0], 32); sc[0] = lt > 0.f ? gt[0][2] / lt : 0.f; attn_flush<false>(st, sc, orow); }
}
#define LAS __attribute__((address_space(3)))
constexpr size_t WS_CTL = WS_W1T + 524288;
constexpr size_t CTL_BYTES = 16384;
#define XB_TMO      128
#define XB_XCNT(j)  (256  + 64 * (j))
#define XB_XSUB(j)  (1280 + 64 * (j))
#define XB_XGEN(j)  (2304 + 64 * (j))
#define XB_TOP      3328
#define XB_TOPGEN   3392
#define XCD_BAR_WORDS 3456
#define XB_SPIN_CAP (1u << 18)

__device__ __forceinline__ unsigned xb_ld(unsigned* p)              { return __hip_atomic_load(p, __ATOMIC_RELAXED, __HIP_MEMORY_SCOPE_AGENT); }
__device__ __forceinline__ unsigned xb_add(unsigned* p, unsigned v) { return __hip_atomic_fetch_add(p, v, __ATOMIC_RELAXED, __HIP_MEMORY_SCOPE_AGENT); }
__device__ __forceinline__ unsigned xb_xcc_id() { return (unsigned)__builtin_amdgcn_s_getreg((3 << 11) | 20) & 0xFu; }
#define XB_SPIN(cond, bar) do { unsigned _sp = 0; while (cond) { __builtin_amdgcn_s_sleep(1); \
    if ((++_sp & 255u) == 0u) { if (xb_ld(&(bar)[XB_TMO])) break; if (_sp > XB_SPIN_CAP) { atomicAdd(&(bar)[XB_TMO], 1u); break; } } } } while (0)

struct XcdBarrier {
    unsigned* bar; unsigned x;
    volatile LAS unsigned* st;
};

__device__ __forceinline__ XcdBarrier xcd_barrier_post(unsigned* bar, volatile LAS unsigned* st) {
    XcdBarrier b; b.bar = bar; b.x = xb_xcc_id(); b.st = st;
    if (threadIdx.x == 0) (void)xb_add(&bar[XB_XCNT(b.x)], 1u);
    return b;
}
__device__ __forceinline__ void xcd_barrier_complete(unsigned* bar, unsigned x, unsigned& nloc, unsigned& nx) {
    const unsigned G = gridDim.x * gridDim.y * gridDim.z;
    unsigned sum, cnt, mine, sp = 0u;
    for (;;) {
        sum = 0u; cnt = 0u; mine = 0u;
#pragma unroll
        for (unsigned j = 0; j < 16; ++j) { const unsigned c = xb_ld(&bar[XB_XCNT(j)]); sum += c; cnt += (c > 0u) ? 1u : 0u; mine = (j == x) ? c : mine; }
        if (sum == G) break;
        __builtin_amdgcn_s_sleep(1);
        if ((++sp & 255u) == 0u) { if (xb_ld(&bar[XB_TMO])) break; if (sp > XB_SPIN_CAP) { atomicAdd(&bar[XB_TMO], 1u); break; } }
    }
    nloc = mine > 0u ? mine : 1u; nx = cnt > 0u ? cnt : 1u;
}

__device__ __forceinline__ void xcd_barrier(const XcdBarrier& b) {
    asm volatile("s_waitcnt vmcnt(0)" ::: "memory");
    __syncthreads();
    if (threadIdx.x == 0) {
        unsigned* bar = b.bar;
        __builtin_amdgcn_s_waitcnt(0);
        unsigned nloc = b.st[0], nx = b.st[1];
        if (nloc == 0u) { xcd_barrier_complete(bar, b.x, nloc, nx); b.st[0] = nloc; b.st[1] = nx; }
        const unsigned old = xb_add(&bar[XB_XSUB(b.x)], 1u);
        const unsigned gen = old / nloc;
        if (old + 1u == (gen + 1u) * nloc) {
            __builtin_amdgcn_fence(__ATOMIC_RELEASE, "agent");
            asm volatile("s_waitcnt vmcnt(0)" ::: "memory");
            const unsigned og = xb_add(&bar[XB_TOP], 1u);
            const unsigned tg = og / nx;
            if (og + 1u == (tg + 1u) * nx) xb_add(&bar[XB_TOPGEN], 1u);
            else XB_SPIN(xb_ld(&bar[XB_TOPGEN]) == tg, bar);
            __builtin_amdgcn_fence(__ATOMIC_ACQUIRE, "agent");
            xb_add(&bar[XB_XGEN(b.x)], 1u);
            asm volatile("s_waitcnt vmcnt(0)" ::: "memory");
        } else {
            XB_SPIN(xb_ld(&bar[XB_XGEN(b.x)]) == gen, bar);
            __builtin_amdgcn_fence(__ATOMIC_ACQUIRE, "agent");
            asm volatile("s_waitcnt vmcnt(0)" ::: "memory");
        }
    }
    __syncthreads();
}

constexpr int PPL = 9, N_PHASES = 1 + PPL * DEPTH;
typedef const Args __attribute__((address_space(4)))* KArgP;
DI KArgP launder(KArgP p) { asm volatile("" : "+s"(p)); return p; }
DI Args load_args(KArgP p) { Args a;
#pragma unroll
    for (int i = 0; i < 19; ++i) a.in[i] = p->in[i];
    a.out = p->out; a.ws = p->ws; a.ph_lo = 0; a.ph_hi = 0; a.coop = 0; a.pad = 0; return a; }
__global__ void __launch_bounds__(512, 2) fwd_kernel(Args a_unused) {
    extern __shared__ __attribute__((aligned(16))) unsigned char lds[];
    cg::grid_group grid = cg::this_grid();
    const KArgP kp = (KArgP)__builtin_amdgcn_kernarg_segment_ptr();
    volatile LAS unsigned* bst = (volatile LAS unsigned*)((LAS unsigned char*)lds + (LDS_BYTES - 64));
    if (threadIdx.x < 2) bst[threadIdx.x] = 0u;
    __syncthreads();
    (void)xcd_barrier_post((unsigned*)(kp->ws + WS_CTL), bst);
    const int ph_lo = kp->ph_lo, ph_hi = kp->ph_hi, coop = kp->coop;
#define WSP(T, off) ((T*)(a.ws + (off)))
#define SSA WSP(float, WS_SSA)
#define SSB WSP(float, WS_SSB)
#define XB WSP(bf16_t, WS_XB)
#define Z1 WSP(bf16_t, WS_Z1)
#define OUTS WSP(bf16_t, WS_OUTS)
#define WIN WSP(bf16_t, WS_WIN)
#define WB WSP(bf16_t, WS_WB)
#define WO WSP(bf16_t, WS_WO)
#define WUP WSP(bf16_t, WS_WUP)
#define WDN WSP(bf16_t, WS_WDN)
#define LOD ((bf16_t*)((unsigned char*)a.out + (size_t)MROWS * DM * 2))
#define LOW WSP(bf16_t, WS_Z1 + 192 * MiB)
    for (int p = ph_lo; p < ph_hi; ++p) {
        if (p > ph_lo && coop) { if (p == ph_lo + 1) grid.sync(); else { XcdBarrier b2; b2.bar = (unsigned*)(launder(kp)->ws + WS_CTL); b2.x = xb_xcc_id(); b2.st = (volatile LAS unsigned*)((LAS unsigned char*)lds + (LDS_BYTES - 64)); xcd_barrier(b2); } }
        const Args a = load_args(launder(kp)); int tid = threadIdx.x; asm volatile("" : "+v"(tid)); int G = gridDim.x; asm volatile("" : "+s"(G)); const int bid = blockIdx.x, ngw = G * 8, ngt = G * 512;
        const int lane = tid & 63, wave = __builtin_amdgcn_readfirstlane(tid >> 6), gw = bid * 8 + wave, gtid = bid * 512 + tid; float* scr = (float*)(lds + wave * 8448);
        PG8_LAS unsigned char* glds = (PG8_LAS unsigned char*)lds;
        const int l = (p == 0) ? 0 : (p - 1) / PPL, k = (p == 0) ? -1 : (p - 1) % PPL;
        float* ss1 = SSA; float* ss2 = SSB; float* ss3 = SSA;
        bool is_gemm = false; pg8::Gemm g{nullptr, nullptr, MROWS, 0, 0, 0, 0, 0}; pg8::EpiAny E{0, nullptr, 0, 0, nullptr, nullptr, nullptr, nullptr, nullptr};
        switch (k) {
        case -1:
            for (int m = gw; m < MROWS; m += 2 * ngw) {
                const int m2 = m + ngw; const bool two = m2 < MROWS;
                f32x4 va[4], vb[4];
#pragma unroll
                for (int j = 0; j < 4; ++j) { va[j] = ((const f32x4*)(a.in[0] + (size_t)m * DM) + lane)[64 * j]; vb[j] = two ? ((const f32x4*)(a.in[0] + (size_t)m2 * DM) + lane)[64 * j] : (f32x4){0.f, 0.f, 0.f, 0.f}; }
                float sa = 0.f, sbq = 0.f;
#pragma unroll
                for (int j = 0; j < 4; ++j) { sa += (va[j].x * va[j].x + va[j].y * va[j].y) + (va[j].z * va[j].z + va[j].w * va[j].w); sbq += (vb[j].x * vb[j].x + vb[j].y * vb[j].y) + (vb[j].z * vb[j].z + vb[j].w * vb[j].w); }
                sa = wave_sum(sa); sbq = wave_sum(sbq);
#pragma unroll
                for (int j = 0; j < 4; ++j) { u32x2 w; w.x = cvtpk(va[j].x, va[j].y); w.y = cvtpk(va[j].z, va[j].w); ((u32x2*)(XB + (size_t)m * DM) + lane)[64 * j] = w;
                    u32x2 wl; wl.x = cvtpk(va[j].x - bflo(w.x), va[j].y - bfhi(w.x)); wl.y = cvtpk(va[j].z - bflo(w.y), va[j].w - bfhi(w.y)); ((u32x2*)(LOD + (size_t)m * DM) + lane)[64 * j] = wl;
                    if (two) { u32x2 w2; w2.x = cvtpk(vb[j].x, vb[j].y); w2.y = cvtpk(vb[j].z, vb[j].w); ((u32x2*)(XB + (size_t)m2 * DM) + lane)[64 * j] = w2;
                        u32x2 wl2; wl2.x = cvtpk(vb[j].x - bflo(w2.x), vb[j].y - bfhi(w2.x)); wl2.y = cvtpk(vb[j].z - bflo(w2.y), vb[j].w - bfhi(w2.y)); ((u32x2*)(LOD + (size_t)m2 * DM) + lane)[64 * j] = wl2; } }
                if (lane < 16) { (SSA + (size_t)m * 16)[lane] = (lane == 0) ? sa : 0.f; if (two) (SSA + (size_t)m2 * 16)[lane] = (lane == 0) ? sbq : 0.f; }
            }
            convert_first(a, 0, scr, gw, ngw, lane);
            break;
        case 0:
            g = pg8::Gemm{XB, WIN, MROWS, 4608, 1024, 1024, 0, 0}; E = pg8::EpiAny{0, Z1, ZP, ZP, ss1, nullptr, nullptr, nullptr, nullptr}; is_gemm = true; break;
        case 1:
            convert_second(a, l, scr, gw, ngw, lane);
            __syncthreads();
            for (int it = bid; it < 1824; it += G) {
                int t2 = tid; asm volatile("" : "+v"(t2));
                if (it < 256) sgu_item(a, l, it, lds, t2);
                else if (it < 768) prep_item(a, l, it - 256, lds, t2);
                else if (it < 1280) mix_ac_item(a, l, it - 768, t2);
                else compress_item(a, l, it - 1280, lds, t2);
            }
            break;
        case 2:
            for (int pr0 = bid; pr0 < NB * 2 * 32; pr0 += G) {
                int pr = pr0; if (G == 256) { const int k = pr0 >> 8, x = pr0 & 7, slot = (pr0 >> 3) & 31; pr = ((x + 8 * k) << 5) | slot; }
                const int b = pr >> 6, gg = (pr >> 5) & 1, tb = pr & 31;
                nsa_wg_unit(a, l, b, gg, tb, lds, tid, true); nsa_wg_unit(a, l, b, gg, 63 - tb, lds, tid, false); }
            __syncthreads();
            break;
        case 3:
            g = pg8::Gemm{OUTS, WB, MROWS, 4096, 512, 512, 2, (size_t)MROWS * 512 * 2}; E = pg8::EpiAny{0, Z1, 4096, 4096, nullptr, nullptr, nullptr, nullptr, nullptr}; is_gemm = true; break;
        case 4:
            g = pg8::Gemm{XB, WIN + (size_t)4608 * 1024, MROWS, 4096, 1024, 1024, 0, 0}; E = pg8::EpiAny{2, OUTS, 0, 0, ss1, (const float*)Z1, nullptr, nullptr, nullptr}; is_gemm = true; break;
        case 5:
            g = pg8::Gemm{OUTS, WO, MROWS, 1024, 1024, 1024, 0, 0}; E = pg8::EpiAny{3, XB, 0, 0, (const float*)(l + 1 < DEPTH ? LOD : LOW), (const float*)LOD, nullptr, ss2, nullptr}; is_gemm = true; break;
        case 6:
            g = pg8::Gemm{XB, WUP, MROWS, GUP, 1024, 1024, 0, 0}; E = pg8::EpiAny{4, Z1, 0, 0, ss2, a.in[17] + (size_t)l * 3 * DFF, WSP(float, WS_SB), nullptr, (PG8_LAS float*)(glds + 131072)}; is_gemm = true; break;
        case 7:
            act_fixup(a, l, gtid, ngt);
            if (l + 1 < DEPTH) convert_first(a, l + 1, scr, gw, ngw, lane);
            break;
        default:
            g = pg8::Gemm{Z1, WDN, MROWS, 1024, DFF, DFF, 0, 0}; E = pg8::EpiAny{3, XB, 0, 0, (const float*)LOD, (const float*)(l + 1 < DEPTH ? LOD : LOW), l + 1 < DEPTH ? (float*)nullptr : a.out, ss3, nullptr}; is_gemm = true; break;
        }
        if (is_gemm) { pg8::StaticOrder S; S.init(MROWS, g.N, G, bid); pg8::gemm_phase<pg8::EpiAny, pg8::StaticOrder, true, true>(glds, g, S, E); }
    }
}

#ifndef MK_MULTI
#define MK_MULTI 0
#endif
extern "C" void kernel_launch(void* const* d_in, const int* in_sizes, int n_in, void* d_out, int out_size, void* d_ws, size_t ws_size, hipStream_t stream) {
    static int grid = 0;
    if (grid == 0) {
        if (n_in != 19 || out_size != MROWS * DM || ws_size < WS_NEED) { fprintf(stderr, "kernel_launch: unexpected problem: n_in %d out %d ws %zu (need %zu)\n", n_in, out_size, ws_size, (size_t)WS_NEED); grid = -1; return; }
        int dev = 0, cus = 0, per_cu = 0;
        hipGetDevice(&dev); hipDeviceGetAttribute(&cus, hipDeviceAttributeMultiprocessorCount, dev);
        if (hipFuncSetAttribute((const void*)fwd_kernel, hipFuncAttributeMaxDynamicSharedMemorySize, LDS_BYTES) != hipSuccess) { fprintf(stderr, "kernel_launch: hipFuncSetAttribute failed\n"); grid = -1; return; }
        if (hipOccupancyMaxActiveBlocksPerMultiprocessor(&per_cu, (const void*)fwd_kernel, 512, LDS_BYTES) != hipSuccess || per_cu < 1) { fprintf(stderr, "kernel_launch: occupancy query failed (%d)\n", per_cu); per_cu = 1; (void)hipGetLastError(); }
        grid = cus * 1;
        (void)per_cu;
    }
    if (grid < 0) return;
    if (hipMemsetAsync((char*)d_ws + WS_CTL, 0, CTL_BYTES, stream) != hipSuccess) { fprintf(stderr, "kernel_launch: memset failed\n"); return; }
    Args a{};
    for (int i = 0; i < 19; ++i) a.in[i] = (const float*)d_in[i];
    a.out = (float*)d_out; a.ws = (unsigned char*)d_ws;
#if MK_MULTI
    for (int p = 0; p < N_PHASES; ++p) { a.ph_lo = p; a.ph_hi = p + 1; a.coop = 0; a.pad = 0; hipLaunchKernelGGL(fwd_kernel, dim3(grid), dim3(512), LDS_BYTES, stream, a); }
#else
    a.ph_lo = 0; a.ph_hi = N_PHASES; a.coop = 1; a.pad = 0;
    void* args[] = {&a};
    hipError_t e = hipLaunchCooperativeKernel((const void*)fwd_kernel, dim3(grid), dim3(512), args, LDS_BYTES, stream);
    if (e != hipSuccess) fprintf(stderr, "kernel_launch: cooperative launch failed: %s (grid %d)\n", hipGetErrorString(e), grid);
#endif
}
```

```cpp
#include <hip/hip_runtime.h>
#include <hip/hip_cooperative_groups.h>
#include <cstdio>
#include <cstdint>
#include <cmath>
namespace cg = cooperative_groups;
namespace pg8 {
#define PG8_LAS __attribute__((address_space(3)))
typedef unsigned short bf16_t;
typedef short bf16x8 __attribute__((ext_vector_type(8)));
typedef float f32x4 __attribute__((ext_vector_type(4)));
typedef unsigned u32x4 __attribute__((ext_vector_type(4)));
constexpr int BM = 256, BK = 64, HALF = 128, HTB = HALF * BK * 2  , STAGE_BYTES = 8 * HTB, NXCD = 8, WGM = 8;

__host__ __device__ __forceinline__ int lds_byte(int r, int c) { const int st = (r >> 4) * 2 + (c >> 5), rr = r & 15, cc = c & 31, ob = rr * 64 + cc * 2; return st * 1024 + (ob ^ (((ob >> 9) & 1) << 5)); }
__host__ __device__ __forceinline__ void stage_rc(int b, int& R, int& C) { const int st = b / 1024, sb = b % 1024, swz = sb ^ (((sb >> 9) & 1) << 5); R = (st >> 1) * 16 + swz / 64; C = (st & 1) * 32 + (swz % 64) / 2; }
__host__ __device__ __forceinline__ int perm32(int rho) { const int n = rho >> 4, i = rho & 15; return 8 * (i >> 2) + 4 * n + (i & 3); }

struct Unit { int pm, pn; };
struct Gemm { const bf16_t* A; const bf16_t* Bt; int M, N, K, lda, agshift; size_t agstride; };

struct StaticOrder {
    int nM, nN, nwg, G, c, rev;
    __host__ __device__ void init(int M, int N, int G_, int c_) { nM = M / BM; nN = N / BM; nwg = nM * nN; G = G_; c = c_; rev = 0; }
    __host__ __device__ bool next(int i, Unit& u) const {
        const int nr = nwg / G; const long L = (long)((rev && nwg % G == 0) ? (i < nr ? nr - 1 - i : i) : i) * G + c; if (L >= nwg) return false;
        int wgid = (int)L; { const int q = nwg / NXCD, r = nwg % NXCD, xcd = wgid % NXCD, off = wgid / NXCD; wgid = (xcd < r ? xcd * (q + 1) : r * (q + 1) + (xcd - r) * q) + off; }
        const int nig = WGM * nN, gid = wgid / nig, fm = gid * WGM, gsz = (nM - fm) < WGM ? (nM - fm) : WGM;
        u.pm = fm + ((wgid % nig) % gsz); u.pn = (wgid % nig) / gsz; return true;
    }
    __device__ __forceinline__ void a_ready(const Unit&) const {}
    __device__ __forceinline__ void done(const Unit&) const {}
};


template <class Epi, class Sched, bool ALIGN_EPI = false, bool SP2 = false>
__device__ __forceinline__ void gemm_phase(PG8_LAS unsigned char* lds, const Gemm g, const Sched& S, const Epi& E) {
    int tid_ = threadIdx.x; asm volatile("" : "+v"(tid_));
    const int tid = tid_, wid = __builtin_amdgcn_readfirstlane(tid >> 6), lane = tid & 63, wr = wid >> 2, wc = wid & 3, fr = lane & 15, fq = lane >> 4;
    const int K = g.K, nt = K / BK;
    unsigned voffA[2], voffB[2];
#pragma unroll
    for (int i = 0; i < 2; ++i) { int R, C; stage_rc(tid * 16 + i * 8192, R, C); const int Rb = Epi::PERM ? ((R & ~31) + perm32(R & 31)) : R;
        voffA[i] = (unsigned)(R * g.lda + C) * 2u; voffB[i] = (unsigned)(Rb * K + C) * 2u; }
    const size_t kstep = (size_t)(BK * 2);
    const size_t hstepB = (size_t)HALF * K * 2; const size_t hstepA = (size_t)HALF * g.lda * 2;
    const size_t tstepB = 2 * hstepB; const size_t tstepA = 2 * hstepA;
    const unsigned ldsw = (unsigned)wid * 1024u;
    const int aoff = lds_byte(wr * 64 + fr, fq * 8), boff = lds_byte(wc * 32 + fr, fq * 8);
#define PG8_SA(b, h) (((b) * 2 + (h)) * HTB)
#define PG8_SB(b, h) ((4 + (b) * 2 + (h)) * HTB)
#define PG8_STAGE(bufoff, gbase, voff) do { _Pragma("unroll") for (int _i = 0; _i < 2; ++_i) \
        __builtin_amdgcn_global_load_lds((const unsigned*)((const char*)(gbase) + (voff)[_i]), (PG8_LAS unsigned*)(lds + (bufoff) + ldsw + _i * 8192), 16, 0, 0); } while (0)
#define PG8_LDA(dst, b, h) do { _Pragma("unroll") for (int m = 0; m < 4; ++m) _Pragma("unroll") for (int k = 0; k < 2; ++k) dst[m][k] = *(const PG8_LAS bf16x8*)(lds + PG8_SA(b, h) + aoff + m * 2048 + k * 1024); } while (0)
#define PG8_LDB(dst, b, h) do { _Pragma("unroll") for (int n = 0; n < 2; ++n) _Pragma("unroll") for (int k = 0; k < 2; ++k) dst[n][k] = *(const PG8_LAS bf16x8*)(lds + PG8_SB(b, h) + boff + n * 2048 + k * 1024); } while (0)
#define PG8_MMA(ai, bj, At, Bt) do { __builtin_amdgcn_s_setprio(1); _Pragma("unroll") for (int m = 0; m < 4; ++m) _Pragma("unroll") for (int n = 0; n < 2; ++n) _Pragma("unroll") for (int k = 0; k < 2; ++k) \
        acc[ai][bj][m][n] = __builtin_amdgcn_mfma_f32_16x16x32_bf16(Bt[n][k], At[m][k], acc[ai][bj][m][n], 0, 0, 0); __builtin_amdgcn_s_setprio(0); } while (0)
#define PG8_WAIT_V(n) asm volatile("s_waitcnt vmcnt(" #n ")" ::: "memory")
#define PG8_WAIT_L(n) asm volatile("s_waitcnt lgkmcnt(" #n ")" ::: "memory")
#define PG8_BAR __builtin_amdgcn_s_barrier()
#define PG8_SCHED __builtin_amdgcn_sched_barrier(0)
    Unit cur, nxt; int ui = 0;
    if (!S.next(0, cur)) return;
    f32x4 acc[2][2][4][2];
#pragma unroll
    for (int a = 0; a < 2; ++a)
#pragma unroll
        for (int b = 0; b < 2; ++b)
#pragma unroll
            for (int m = 0; m < 4; ++m)
#pragma unroll
                for (int n = 0; n < 2; ++n) acc[a][b][m][n] = (f32x4){0.f, 0.f, 0.f, 0.f};
    bf16x8 At[4][2], B0[2][2], B1[2][2];
    const char* cA = (const char*)g.A + (size_t)cur.pm * tstepA + (size_t)(cur.pn >> g.agshift) * g.agstride; const char* cB = (const char*)g.Bt + (size_t)cur.pn * tstepB;
    S.a_ready(cur);
    if constexpr (SP2) {
        PG8_STAGE(PG8_SB(0, 0), cB, voffB); PG8_STAGE(PG8_SB(0, 1), cB + hstepB, voffB); PG8_STAGE(PG8_SA(0, 0), cA, voffA); PG8_STAGE(PG8_SA(0, 1), cA + hstepA, voffA);
        if (wr == 1) PG8_BAR;
        PG8_WAIT_V(2); PG8_BAR;
        PG8_STAGE(PG8_SB(1, 0), cB + kstep, voffB); PG8_STAGE(PG8_SA(1, 0), cA + kstep, voffA); PG8_STAGE(PG8_SB(1, 1), cB + hstepB + kstep, voffB);
        PG8_WAIT_V(6); PG8_BAR;
    } else {
        PG8_STAGE(PG8_SB(0, 0), cB, voffB); PG8_STAGE(PG8_SA(0, 0), cA, voffA); PG8_STAGE(PG8_SB(0, 1), cB + hstepB, voffB); PG8_STAGE(PG8_SA(0, 1), cA + hstepA, voffA);
        if (wr == 1) PG8_BAR;
        PG8_WAIT_V(4); PG8_BAR;
        PG8_STAGE(PG8_SB(1, 0), cB + kstep, voffB); PG8_STAGE(PG8_SA(1, 0), cA + kstep, voffA); PG8_STAGE(PG8_SB(1, 1), cB + hstepB + kstep, voffB);
        PG8_WAIT_V(6); PG8_BAR;
    }
    for (;;) {
        const bool has_next = S.next(ui + 1, nxt);
        const char* nA = has_next ? (const char*)g.A + (size_t)nxt.pm * tstepA + (size_t)(nxt.pn >> g.agshift) * g.agstride : cA; const char* nB = has_next ? (const char*)g.Bt + (size_t)nxt.pn * tstepB : cB;
        for (int t = 0; t < nt; t += 2) {
            const bool last = (t == nt - 2);
            const char* a1 = cA + (size_t)(t + 1) * kstep;
            const char* a2 = last ? nA : cA + (size_t)(t + 2) * kstep; const char* b2 = last ? nB : cB + (size_t)(t + 2) * kstep;
            const char* a3 = a2 + kstep; const char* b3 = b2 + kstep;
            if (last && has_next) S.a_ready(nxt);
            if constexpr (SP2) {
            PG8_LDB(B0, 0, 0); PG8_LDB(B1, 0, 1); PG8_SCHED; PG8_LDA(At, 0, 0); PG8_STAGE(PG8_SA(1, 1), a1 + hstepA, voffA);
            PG8_WAIT_V(8); PG8_WAIT_L(0); PG8_BAR; PG8_MMA(0, 0, At, B0); PG8_MMA(0, 1, At, B1); PG8_BAR; PG8_SCHED;
            PG8_LDA(At, 0, 1); PG8_STAGE(PG8_SB(0, 0), b2, voffB); PG8_STAGE(PG8_SB(0, 1), b2 + hstepB, voffB); PG8_STAGE(PG8_SA(0, 0), a2, voffA);
            PG8_WAIT_V(8); PG8_WAIT_L(0); PG8_BAR; PG8_MMA(1, 0, At, B0); PG8_MMA(1, 1, At, B1); PG8_BAR; PG8_SCHED;
            PG8_LDB(B0, 1, 0); PG8_LDB(B1, 1, 1); PG8_SCHED; PG8_LDA(At, 1, 0); PG8_STAGE(PG8_SA(0, 1), a2 + hstepA, voffA);
            PG8_WAIT_V(8); PG8_WAIT_L(0); PG8_BAR; PG8_MMA(0, 0, At, B0); PG8_MMA(0, 1, At, B1); PG8_BAR; PG8_SCHED;
            PG8_LDA(At, 1, 1); PG8_STAGE(PG8_SB(1, 0), b3, voffB); PG8_STAGE(PG8_SB(1, 1), b3 + hstepB, voffB); PG8_STAGE(PG8_SA(1, 0), a3, voffA);
            PG8_WAIT_V(8); PG8_WAIT_L(0); PG8_BAR; PG8_MMA(1, 0, At, B0); PG8_MMA(1, 1, At, B1); PG8_BAR; PG8_SCHED;
            } else {
            PG8_LDB(B0, 0, 0); PG8_SCHED; PG8_LDA(At, 0, 0); PG8_STAGE(PG8_SA(1, 1), a1 + hstepA, voffA);
            PG8_WAIT_L(8); PG8_BAR; PG8_WAIT_L(0); PG8_MMA(0, 0, At, B0); PG8_BAR; PG8_SCHED;
            PG8_LDB(B1, 0, 1); PG8_STAGE(PG8_SB(0, 0), b2, voffB);
            PG8_BAR; PG8_WAIT_L(0); PG8_MMA(0, 1, At, B1); PG8_BAR;
            PG8_LDA(At, 0, 1); PG8_STAGE(PG8_SA(0, 0), a2, voffA);
            PG8_BAR; PG8_WAIT_L(0); PG8_MMA(1, 0, At, B0); PG8_BAR; PG8_SCHED;
            PG8_STAGE(PG8_SB(0, 1), b2 + hstepB, voffB);
            PG8_WAIT_V(6); PG8_BAR; PG8_MMA(1, 1, At, B1); PG8_BAR;
            PG8_LDB(B0, 1, 0); PG8_SCHED; PG8_LDA(At, 1, 0); PG8_STAGE(PG8_SA(0, 1), a2 + hstepA, voffA);
            PG8_WAIT_L(8); PG8_BAR; PG8_WAIT_L(0); PG8_MMA(0, 0, At, B0); PG8_BAR; PG8_SCHED;
            PG8_LDB(B1, 1, 1); PG8_STAGE(PG8_SB(1, 0), b3, voffB);
            PG8_BAR; PG8_WAIT_L(0); PG8_MMA(0, 1, At, B1); PG8_BAR;
            PG8_LDA(At, 1, 1); PG8_STAGE(PG8_SA(1, 0), a3, voffA);
            PG8_BAR; PG8_WAIT_L(0); PG8_MMA(1, 0, At, B0); PG8_BAR; PG8_SCHED;
            PG8_STAGE(PG8_SB(1, 1), b3 + hstepB, voffB);
            PG8_WAIT_V(6); PG8_BAR; PG8_MMA(1, 1, At, B1); PG8_BAR;
            }
        }
        if constexpr (ALIGN_EPI) { if (wr == 0) PG8_BAR; }
        if constexpr (!Epi::AFTER_DRAIN) { E(acc, cur, wr, wc, fr, fq); S.done(cur); }
        if (!has_next) break;
#pragma unroll
        for (int a = 0; a < 2; ++a)
#pragma unroll
            for (int b = 0; b < 2; ++b)
#pragma unroll
                for (int m = 0; m < 4; ++m)
#pragma unroll
                    for (int n = 0; n < 2; ++n) acc[a][b][m][n] = (f32x4){0.f, 0.f, 0.f, 0.f};
        cur = nxt; cA = nA; cB = nB; ++ui;
        if constexpr (ALIGN_EPI) { if (wr == 1) PG8_BAR; }
    }
    PG8_WAIT_V(0);
    if constexpr (!ALIGN_EPI) { if (wr == 0) PG8_BAR; }
    PG8_BAR;
    if constexpr (Epi::AFTER_DRAIN) { E.fused(acc, cur, wr, wc, fr, fq, lds, wid, lane); S.done(cur); }
#undef PG8_SA
#undef PG8_SB
#undef PG8_STAGE
#undef PG8_LDA
#undef PG8_LDB
#undef PG8_MMA
#undef PG8_WAIT_V
#undef PG8_WAIT_L
#undef PG8_BAR
#undef PG8_SCHED
}
}
namespace pg8 {
__device__ __forceinline__ unsigned cvt_pk_bf16(float lo, float hi) { typedef float f2 __attribute__((ext_vector_type(2))); typedef __bf16 b2 __attribute__((ext_vector_type(2))); f2 v = {lo, hi}; b2 b = __builtin_convertvector(v, b2); return __builtin_bit_cast(unsigned, b); }
__device__ __forceinline__ float bf_lo(unsigned w) { return __uint_as_float(w << 16); }
__device__ __forceinline__ float bf_hi(unsigned w) { return __uint_as_float(w & 0xffff0000u); }
template <int SIG> struct EpiScale {
    static constexpr bool PERM = true, AFTER_DRAIN = false;
    bf16_t* O; int ldc; int ncols; const float* ss;
    __device__ __forceinline__ void operator()(f32x4 (&acc)[2][2][4][2], const Unit& u, int wr, int wc, int fr, int fq) const {
        const int row0 = u.pm * BM + wr * 64 + fr; const int col0 = u.pn * BM + wc * 32 + 8 * fq;
        float rs[2][4];
        if (ss) { f32x4 pv[2][4];
#pragma unroll
            for (int ai = 0; ai < 2; ++ai)
#pragma unroll
                for (int m = 0; m < 4; ++m) pv[ai][m] = *(const f32x4*)(ss + (size_t)(row0 + ai * HALF + m * 16) * 16 + 4 * fq);
#pragma unroll
            for (int ai = 0; ai < 2; ++ai)
#pragma unroll
                for (int m = 0; m < 4; ++m) { float sq = (pv[ai][m][0] + pv[ai][m][1]) + (pv[ai][m][2] + pv[ai][m][3]); sq += __shfl_xor(sq, 16); sq += __shfl_xor(sq, 32); rs[ai][m] = rsqrtf(sq * (1.0f / 1024.0f) + 1e-6f); } }
        else {
#pragma unroll
            for (int ai = 0; ai < 2; ++ai)
#pragma unroll
                for (int m = 0; m < 4; ++m) rs[ai][m] = 1.0f; }
#pragma unroll
        for (int ai = 0; ai < 2; ++ai)
#pragma unroll
            for (int m = 0; m < 4; ++m) { const int row = row0 + ai * HALF + m * 16; bf16_t* rowp = O + (size_t)row * ldc;
#pragma unroll
                for (int bj = 0; bj < 2; ++bj) { const int col = col0 + bj * HALF; f32x4 v0 = acc[ai][bj][m][0] * rs[ai][m], v1 = acc[ai][bj][m][1] * rs[ai][m];
                    if (SIG) {
#pragma unroll
                        for (int e = 0; e < 4; ++e) { v0[e] = 1.0f / (1.0f + __expf(-v0[e])); v1[e] = 1.0f / (1.0f + __expf(-v1[e])); } }
                    u32x4 w; w.x = cvt_pk_bf16(v0[0], v0[1]); w.y = cvt_pk_bf16(v0[2], v0[3]); w.z = cvt_pk_bf16(v1[0], v1[1]); w.w = cvt_pk_bf16(v1[2], v1[3]);
                    if (col < ncols) *(u32x4*)(rowp + col) = w; } }
    }
};
struct EpiMerge {
    static constexpr bool PERM = true, AFTER_DRAIN = false;
    bf16_t* O; const bf16_t* P; const float* ss;
    __device__ __forceinline__ void operator()(f32x4 (&acc)[2][2][4][2], const Unit& u, int wr, int wc, int fr, int fq) const {
        typedef unsigned u32x2_ __attribute__((ext_vector_type(2)));
        const int row0 = u.pm * BM + wr * 64 + fr; const int c0 = u.pn * 64 + wc * 16 + 4 * fq;
#pragma unroll
        for (int ai = 0; ai < 2; ++ai) { f32x4 pv[4]; u32x2_ pw[4][4];
#pragma unroll
            for (int m = 0; m < 4; ++m) { const int row = row0 + ai * HALF + m * 16; pv[m] = *(const f32x4*)(ss + (size_t)row * 16 + 4 * fq); const bf16_t* prow = P + (size_t)row * 4096 + c0;
#pragma unroll
                for (int i = 0; i < 4; ++i) pw[m][i] = *(const u32x2_*)(prow + i * 1024); }
#pragma unroll
            for (int m = 0; m < 4; ++m) { const int row = row0 + ai * HALF + m * 16; float sq = (pv[m][0] + pv[m][1]) + (pv[m][2] + pv[m][3]); sq += __shfl_xor(sq, 16); sq += __shfl_xor(sq, 32); const float rs = rsqrtf(sq * (1.0f / 1024.0f) + 1e-6f);
                f32x4 tot = (f32x4){0.f, 0.f, 0.f, 0.f};
#pragma unroll
                for (int bj = 0; bj < 2; ++bj)
#pragma unroll
                    for (int n = 0; n < 2; ++n) { const u32x2_ pq = pw[m][2 * bj + n]; const f32x4 a4 = acc[ai][bj][m][n] * rs; f32x4 gsig;
#pragma unroll
                        for (int e = 0; e < 4; ++e) gsig[e] = __builtin_amdgcn_rcpf(1.0f + __builtin_amdgcn_exp2f(-1.4426950408889634f * a4[e]));
                        tot[0] += gsig[0] * bf_lo(pq.x); tot[1] += gsig[1] * bf_hi(pq.x); tot[2] += gsig[2] * bf_lo(pq.y); tot[3] += gsig[3] * bf_hi(pq.y); }
                u32x2_ w; w.x = cvt_pk_bf16(tot[0], tot[1]); w.y = cvt_pk_bf16(tot[2], tot[3]);
                *(u32x2_*)(O + (size_t)row * 1024 + c0) = w; } }
    }
};
struct EpiRes {
    static constexpr bool PERM = true, AFTER_DRAIN = false;
    const bf16_t* loin; bf16_t* loout; bf16_t* xb; float* ss; float* fout;
    __device__ __forceinline__ void operator()(f32x4 (&acc)[2][2][4][2], const Unit& u, int wr, int wc, int fr, int fq) const {
        const int row0 = u.pm * BM + wr * 64 + fr; const int col0 = u.pn * BM + wc * 32 + 8 * fq;
#pragma unroll
        for (int am = 0; am < 4; ++am) { const int ai = am >> 1; u32x4 hh[4][2], ll[4][2];
#pragma unroll
            for (int m = 2 * (am & 1); m < 2 * (am & 1) + 2; ++m) { const size_t off = (size_t)(row0 + ai * HALF + m * 16) * 1024 + col0;
#pragma unroll
                for (int bj = 0; bj < 2; ++bj) { hh[m][bj] = *(const u32x4*)(xb + off + bj * HALF); ll[m][bj] = *(const u32x4*)(loin + off + bj * HALF); } }
#pragma unroll
            for (int m = 2 * (am & 1); m < 2 * (am & 1) + 2; ++m) { const int row = row0 + ai * HALF + m * 16; const size_t off = (size_t)row * 1024 + col0; float sq = 0.f;
#pragma unroll
                for (int bj = 0; bj < 2; ++bj) { const u32x4 h4 = hh[m][bj], l4 = ll[m][bj]; f32x4 v0, v1;
                    v0[0] = acc[ai][bj][m][0][0] + (bf_lo(h4.x) + bf_lo(l4.x)); v0[1] = acc[ai][bj][m][0][1] + (bf_hi(h4.x) + bf_hi(l4.x)); v0[2] = acc[ai][bj][m][0][2] + (bf_lo(h4.y) + bf_lo(l4.y)); v0[3] = acc[ai][bj][m][0][3] + (bf_hi(h4.y) + bf_hi(l4.y));
                    v1[0] = acc[ai][bj][m][1][0] + (bf_lo(h4.z) + bf_lo(l4.z)); v1[1] = acc[ai][bj][m][1][1] + (bf_hi(h4.z) + bf_hi(l4.z)); v1[2] = acc[ai][bj][m][1][2] + (bf_lo(h4.w) + bf_lo(l4.w)); v1[3] = acc[ai][bj][m][1][3] + (bf_hi(h4.w) + bf_hi(l4.w));
                    if (fout) { *(f32x4*)(fout + off + bj * HALF) = v0; *(f32x4*)(fout + off + bj * HALF + 4) = v1; }
                    else { u32x4 w; w.x = cvt_pk_bf16(v0[0], v0[1]); w.y = cvt_pk_bf16(v0[2], v0[3]); w.z = cvt_pk_bf16(v1[0], v1[1]); w.w = cvt_pk_bf16(v1[2], v1[3]);
                        u32x4 wl; wl.x = cvt_pk_bf16(v0[0] - bf_lo(w.x), v0[1] - bf_hi(w.x)); wl.y = cvt_pk_bf16(v0[2] - bf_lo(w.y), v0[3] - bf_hi(w.y)); wl.z = cvt_pk_bf16(v1[0] - bf_lo(w.z), v1[1] - bf_hi(w.z)); wl.w = cvt_pk_bf16(v1[2] - bf_lo(w.w), v1[3] - bf_hi(w.w));
                        *(u32x4*)(xb + off + bj * HALF) = w; *(u32x4*)(loout + off + bj * HALF) = wl;
                        sq += (v0[0] * v0[0] + v0[1] * v0[1]) + (v0[2] * v0[2] + v0[3] * v0[3]) + (v1[0] * v1[0] + v1[1] * v1[1]) + (v1[2] * v1[2] + v1[3] * v1[3]); } }
                if (!fout) { sq += __shfl_xor(sq, 16); sq += __shfl_xor(sq, 32);
                    if (fq == 0) ss[(size_t)row * 16 + u.pn * 4 + wc] = sq; } } }
    }
};
template <int CTRL> __device__ __forceinline__ float dpp_ror(float v) { return __builtin_bit_cast(float, __builtin_amdgcn_mov_dpp(__builtin_bit_cast(int, v), CTRL, 0xf, 0xf, false)); }
struct EpiAct {
    bf16_t* O; const float* ss; const float* cw; float* sb; PG8_LAS float* xl;
    __device__ __forceinline__ void operator()(f32x4 (&acc)[2][2][4][2], const Unit& u, int wr, int wc, int fr_in, int fq_in) const {
        int fr = fr_in, fq = fq_in; asm volatile("" : "+v"(fr), "+v"(fq));
        const int lane = fq * 16 + fr, wave = wr * 4 + wc; const int row0 = u.pm * BM + wr * 64 + fr; const int cb = u.pn * 128 + wc * 32 + 8 * fq;
#pragma unroll
        for (int ai = 0; ai < 2; ++ai)
#pragma unroll
            for (int m = 0; m < 4; ++m) { const int row = row0 + ai * HALF + m * 16; const f32x4 pv = *(const f32x4*)(ss + (size_t)row * 16 + 4 * fq); float sq = (pv[0] + pv[1]) + (pv[2] + pv[3]); sq += __shfl_xor(sq, 16); sq += __shfl_xor(sq, 32); const float rs = rsqrtf(sq * (1.0f / 1024.0f) + 1e-6f);
#pragma unroll
                for (int bj = 0; bj < 2; ++bj)
#pragma unroll
                    for (int n = 0; n < 2; ++n) acc[ai][bj][m][n] = acc[ai][bj][m][n] * rs; }
        if (fr >= 14) {
#pragma unroll
            for (int ai = 0; ai < 2; ++ai) { PG8_LAS float* x = xl + ((((wave * 2 + ai) * 2 + (fr - 14)) * 4 + fq) * 8); *(PG8_LAS f32x4*)x = acc[ai][0][3][0]; *(PG8_LAS f32x4*)(x + 4) = acc[ai][0][3][1]; }
            if (wr == 1) { float* s = sb + ((size_t)(0 * 128 + u.pm) * 2 + (fr - 14)) * 2816 + cb; *(f32x4*)s = acc[1][0][3][0]; *(f32x4*)(s + 4) = acc[1][0][3][1]; } }
        if (wr == 0 && fr < 2) { float* s = sb + ((size_t)(1 * 128 + u.pm) * 2 + fr) * 2816 + cb; *(f32x4*)s = acc[0][0][0][0]; *(f32x4*)(s + 4) = acc[0][0][0][1];
            float* t = sb + ((size_t)(2 * 128 + u.pm) * 2 + fr) * 2816 + cb; *(f32x4*)t = acc[0][1][0][0]; *(f32x4*)(t + 4) = acc[0][1][0][1]; }
        asm volatile("s_waitcnt lgkmcnt(0)" ::: "memory"); __builtin_amdgcn_s_barrier(); asm volatile("" ::: "memory");
#pragma unroll
        for (int ai = 0; ai < 2; ++ai)
#pragma unroll
            for (int m = 0; m < 4; ++m) {
                const bool skip = (ai == 0) && (m == 0) && (wr == 0) && (fr < 2);
                bf16_t* op = O + (size_t)(row0 + ai * HALF + m * 16) * 2816 + cb;
#pragma unroll
                for (int n = 0; n < 2; ++n) { f32x4 p1, p2;
                    if (m == 0) { const int sai = (wr == 1) ? ai : (ai > 0 ? ai - 1 : 0); const int swave = (wr ^ 1) * 4 + wc;
                        p1 = *(const PG8_LAS f32x4*)(xl + ((((swave * 2 + sai) * 2 + 1) * 4 + fq) * 8) + 4 * n); p2 = *(const PG8_LAS f32x4*)(xl + ((((swave * 2 + sai) * 2 + (fr == 0 ? 0 : 1)) * 4 + fq) * 8) + 4 * n); }
#pragma unroll
                    for (int e = 0; e < 4; ++e) { const float gv = acc[ai][0][m][n][e]; const float s1 = dpp_ror<0x121>(gv), s2 = dpp_ror<0x122>(gv); float q1, q2;
                        if (m > 0) { const float pvv = acc[ai][0][m > 0 ? m - 1 : 0][n][e]; q1 = dpp_ror<0x121>(pvv); q2 = dpp_ror<0x122>(pvv); } else { q1 = p1[e]; q2 = p2[e]; }
                        p1[e] = fr >= 1 ? s1 : q1; p2[e] = fr >= 2 ? s2 : q2; }
                    const f32x4 w0 = *(const f32x4*)(cw + cb + 4 * n), w1 = *(const f32x4*)(cw + 2816 + cb + 4 * n), w2 = *(const f32x4*)(cw + 2 * 2816 + cb + 4 * n);
                    const f32x4 cv = w0 * p2 + w1 * p1 + w2 * acc[ai][0][m][n]; f32x4 o;
#pragma unroll
                    for (int e = 0; e < 4; ++e) o[e] = cv[e] * __builtin_amdgcn_rcpf(1.0f + __builtin_amdgcn_exp2f(-1.4426950408889634f * cv[e])) * acc[ai][1][m][n][e];
                    typedef unsigned u32x2_ __attribute__((ext_vector_type(2))); u32x2_ wv; wv.x = cvt_pk_bf16(o[0], o[1]); wv.y = cvt_pk_bf16(o[2], o[3]);
                    if (!skip) *(u32x2_*)(op + 4 * n) = wv;
                    asm volatile("" ::: "memory"); } }
    }
};
struct EpiAny {
    static constexpr bool PERM = true, AFTER_DRAIN = false;
    int mode;
    bf16_t* O; int ldc; int ncols; const float* ss; const float* xin; float* xout; float* ssout; PG8_LAS float* xl;
    __device__ __forceinline__ void operator()(f32x4 (&acc)[2][2][4][2], const Unit& u, int wr, int wc, int fr_in, int fq_in) const {
        int fr = fr_in, fq = fq_in; asm volatile("" : "+v"(fr), "+v"(fq));
        if (mode == 0) { EpiScale<0> e{O, ldc, ncols, ss}; e(acc, u, wr, wc, fr, fq); }
        else if (mode == 1) { EpiScale<1> e{O, ldc, ncols, ss}; e(acc, u, wr, wc, fr, fq); }
        else if (mode == 2) { EpiMerge e{O, (const bf16_t*)xin, ss}; e(acc, u, wr, wc, fr, fq); }
        else if (mode == 3) { EpiRes e{(const bf16_t*)xin, (bf16_t*)const_cast<float*>(ss), O, ssout, xout}; e(acc, u, wr, wc, fr, fq); }
        else { EpiAct e{O, ss, xin, xout, xl}; e(acc, u, wr, wc, fr, fq); }
    }
};
}
typedef unsigned short bf16_t;
typedef short bf16x8 __attribute__((ext_vector_type(8)));
typedef short s16x4 __attribute__((ext_vector_type(4)));
typedef float f32x4 __attribute__((ext_vector_type(4)));
typedef float f32x16 __attribute__((ext_vector_type(16)));
typedef unsigned u32x4 __attribute__((ext_vector_type(4)));
typedef unsigned u32x2 __attribute__((ext_vector_type(2)));
constexpr int NB = 8, SEQ = 4096, DM = 1024, MROWS = NB * SEQ, DEPTH = 4;
constexpr int NIN = 8472, ZP = 4376;
constexpr int C_AB = 0, C_AC = 512, C_AX = 1024, C_Q = 1536, C_KV = 2048, C_NG = 2816, C_PL = 2840, C_SG = 3352;
constexpr int NWIN = 8704;
constexpr int DFF = 2816, GUP = 5632;
constexpr float QSC = 0.125f * 1.4426950408889634f;
constexpr size_t MiB = 1u << 20;
constexpr size_t WS_SSA = 0;
constexpr size_t WS_KC = 2 * MiB;
constexpr size_t WS_VCT = WS_KC + 524288;
constexpr size_t WS_W1T = WS_VCT + 524288;
constexpr size_t WS_WIN = 4 * MiB;
constexpr size_t WS_WB = WS_WIN + (size_t)NWIN * 1024 * 2;
constexpr size_t WS_WO = WS_WB + (size_t)4096 * 512 * 2;
constexpr size_t WS_XB = WS_WO + (size_t)1024 * 4096 * 2;
constexpr size_t WS_VT = WS_XB + (size_t)MROWS * 1024 * 2;
constexpr size_t WS_Z1 = WS_VT + (size_t)2 * NB * 2 * 64 * SEQ * 2;
constexpr size_t WS_OUTS = WS_Z1 + (size_t)MROWS * ZP * 2;
constexpr size_t WS_END1 = WS_OUTS + (size_t)4 * MROWS * 512 * 2;
constexpr size_t WS_WDN = WS_WO + 2 * MiB;
static_assert(WS_WDN + (size_t)1024 * DFF * 2 <= WS_XB, "w_down copy fits before xb");
static_assert(WS_W1T + 524288 <= WS_WIN, "small map");
constexpr size_t WS_SSB = WS_END1;
constexpr size_t WS_WUP = WS_SSB + (size_t)MROWS * 16 * 4;
constexpr size_t WS_NEED = WS_WUP + (size_t)GUP * 1024 * 2;
constexpr size_t WS_SB = WS_OUTS + 68 * MiB;
static_assert(WS_SB + (size_t)3 * 128 * 2 * DFF * 4 <= WS_END1, "side buffers inside the outs region");
constexpr int LDS_BYTES = 147456;

struct Args { const float* in[19]; float* out; unsigned char* ws; int ph_lo, ph_hi, coop, pad; };

#define DI __device__ __forceinline__
DI unsigned cvtpk(float lo, float hi) { return pg8::cvt_pk_bf16(lo, hi); }
DI float bflo(unsigned w) { return __uint_as_float(w << 16); }
DI float bfhi(unsigned w) { return __uint_as_float(w & 0xffff0000u); }
DI float bf1(bf16_t v) { return __uint_as_float(((unsigned)v) << 16); }
DI bf16_t f2bf(float f) { return (bf16_t)(cvtpk(f, 0.f) & 0xffffu); }
DI void unpack8(const u32x4 w, float (&f)[8]) { f[0] = bflo(w.x); f[1] = bfhi(w.x); f[2] = bflo(w.y); f[3] = bfhi(w.y); f[4] = bflo(w.z); f[5] = bfhi(w.z); f[6] = bflo(w.w); f[7] = bfhi(w.w); }
DI u32x4 pack8(const float (&f)[8]) { u32x4 w; w.x = cvtpk(f[0], f[1]); w.y = cvtpk(f[2], f[3]); w.z = cvtpk(f[4], f[5]); w.w = cvtpk(f[6], f[7]); return w; }
DI float wave_sum(float v) {
#pragma unroll
    for (int o = 1; o < 64; o <<= 1) v += __shfl_xor(v, o);
    return v; }
#define LDS_FENCE() asm volatile("s_waitcnt lgkmcnt(0)" ::: "memory")

DI void tr_tile(const float* __restrict__ src, int srcN, int k0, int n0, int mode, const float* __restrict__ gk, bf16_t* dst, size_t dpitch, int ncopies, float* scr, int lane) {
    const int nn = lane & 31, n = n0 + nn; int sc = n; bool valid = true;
    if (mode == 1) { if (n >= 4608) { const int q = n - 4608, rho = q & 255; sc = ZP + (2 * (rho >> 7) + ((rho >> 2) & 1)) * 1024 + 64 * (q >> 8) + 16 * ((rho >> 5) & 3) + 4 * ((rho >> 3) & 3) + (rho & 3); } else if (n >= ZP) { sc = 0; valid = false; } }
    if (mode == 2) sc = ((n >> 7) & 1) * DFF + 128 * (n >> 8) + (n & 127);
    float v32[32];
#pragma unroll
    for (int i = 0; i < 32; ++i) { const int kk = 2 * i + (lane >> 5); v32[i] = valid ? src[(size_t)(k0 + kk) * srcN + sc] : 0.f; }
#pragma unroll
    for (int i = 0; i < 32; ++i) { const int kk = 2 * i + (lane >> 5); float v = v32[i]; if (gk) v *= gk[k0 + kk]; scr[kk * 33 + nn] = v; }
    LDS_FENCE();
    const int c = lane & 7;
#pragma unroll
    for (int j = 0; j < 4; ++j) { const int nr = (lane >> 3) + 8 * j; const float* s = scr + (8 * c) * 33 + nr; const int drow = n0 + nr;
        u32x4 o; o.x = cvtpk(s[0], s[33]); o.y = cvtpk(s[2 * 33], s[3 * 33]); o.z = cvtpk(s[4 * 33], s[5 * 33]); o.w = cvtpk(s[6 * 33], s[7 * 33]);
        const bool skip = (mode == 1) && drow >= C_PL && drow < C_PL + 512;
        if (!skip) for (int cp = 0; cp < ncopies; ++cp) *(u32x4*)(dst + (size_t)drow * dpitch + cp * 1024 + k0 + 8 * c) = o; }
    LDS_FENCE();
}
DI void pool_fold_item(const float* __restrict__ win, const float* __restrict__ pw, const float* __restrict__ psc, const float* __restrict__ g1, bf16_t* WIN, int item, int lane) {
    const int kt = item >> 4, nt = item & 15, np = nt * 32 + (lane & 31), gi = np >> 7, d = np & 127, kb = kt * 8 + (lane >> 5) * 4;
    const float* wp = pw + (size_t)gi * 128 * 128 + d; const float sc = psc[np];
    const float* wr = win + (size_t)kb * NIN + C_PL + gi * 128;
    float acc[4] = {0.f, 0.f, 0.f, 0.f};
#pragma unroll 16
    for (int c = 0; c < 128; ++c) { const float w = wp[(size_t)c * 128];
#pragma unroll
        for (int i = 0; i < 4; ++i) acc[i] += wr[(size_t)i * NIN + c] * w; }
    u32x2 o; o.x = cvtpk(acc[0] * sc * g1[kb], acc[1] * sc * g1[kb + 1]); o.y = cvtpk(acc[2] * sc * g1[kb + 2], acc[3] * sc * g1[kb + 3]);
    *(u32x2*)(WIN + (size_t)(C_PL + np) * 1024 + kb) = o;
}
DI void convert_first(const Args& a, int l, float* scr, int gw, int ngw, int lane) {
    unsigned char* ws = a.ws;
    bf16_t* WIN = (bf16_t*)(ws + WS_WIN); bf16_t* WB = (bf16_t*)(ws + WS_WB); bf16_t* WO = (bf16_t*)(ws + WS_WO); bf16_t* W1T = (bf16_t*)(ws + WS_W1T);
    const float* win = a.in[2] + (size_t)l * 1024 * NIN; const float* g1 = a.in[1] + l * 1024;
    constexpr int I_WIN = 16 * (NWIN / 32), I_PF = 2048, I_WB = 4 * 8 * 32, I_WO = 16 * 32, I_W1 = 2 * 32 * 2;
    for (int it = gw; it < I_WIN + I_PF + I_WB + I_WO + I_W1; it += ngw) {
        int r = it;
        if (r < I_WIN) { const int kt = r / (NWIN / 32), nt = r % (NWIN / 32); tr_tile(win, NIN, kt * 64, nt * 32, 1, g1, WIN, 1024, 1, scr, lane); continue; } r -= I_WIN;
        if (r < I_PF) { pool_fold_item(win, a.in[8] + (size_t)l * 4 * 128 * 128, a.in[9] + l * 512, g1, WIN, r, lane); continue; } r -= I_PF;
        if (r < I_WB) { const int i = r >> 8, rr = r & 255, kt = rr >> 5, nt = rr & 31; tr_tile(a.in[13] + ((size_t)l * 4 + i) * 512 * 1024, 1024, kt * 64, nt * 32, 0, nullptr, WB + (size_t)i * 1024 * 512, 512, 1, scr, lane); continue; } r -= I_WB;
        if (r < I_WO) { const int kt = r >> 5, nt = r & 31; tr_tile(a.in[14] + (size_t)l * 1024 * 1024, 1024, kt * 64, nt * 32, 0, nullptr, WO, 1024, 1, scr, lane); continue; } r -= I_WO;
        { const int j = r >> 6, rr = r & 63, kt = rr >> 1, nt = rr & 1; tr_tile(a.in[6] + ((size_t)l * 2 + j) * 2048 * 64, 64, kt * 64, nt * 32, 0, nullptr, W1T + (size_t)j * 64 * 2048, 2048, 1, scr, lane); }
    }
}
DI void convert_second(const Args& a, int l, float* scr, int gw, int ngw, int lane) {
    unsigned char* ws = a.ws;
    bf16_t* WUP = (bf16_t*)(ws + WS_WUP); bf16_t* WDN = (bf16_t*)(ws + WS_WDN);
    constexpr int I_UP = 16 * (GUP / 32), I_DN = (DFF / 64) * 32;
    for (int it = gw; it < I_UP + I_DN; it += ngw) {
        int r = it;
        if (r < I_UP) { const int kt = r / (GUP / 32), nt = r % (GUP / 32); tr_tile(a.in[16] + (size_t)l * 1024 * GUP, GUP, kt * 64, nt * 32, 2, a.in[15] + l * 1024, WUP, 1024, 1, scr, lane); continue; } r -= I_UP;
        { const int kt = r >> 5, nt = r & 31; tr_tile(a.in[18] + (size_t)l * DFF * 1024, 1024, kt * 64, nt * 32, 0, nullptr, WDN, DFF, 1, scr, lane); }
    }
}
DI void row_prep(const float* xrow, bf16_t* xbrow, float* ss, int lane) {
    const f32x4* xr = (const f32x4*)xrow + lane; float s = 0.f; f32x4 v[4];
#pragma unroll
    for (int j = 0; j < 4; ++j) { v[j] = xr[64 * j]; s += (v[j].x * v[j].x + v[j].y * v[j].y) + (v[j].z * v[j].z + v[j].w * v[j].w); }
    s = wave_sum(s);
    u32x2* o = (u32x2*)xbrow + lane;
#pragma unroll
    for (int j = 0; j < 4; ++j) { u32x2 w; w.x = cvtpk(v[j].x, v[j].y); w.y = cvtpk(v[j].z, v[j].w); o[64 * j] = w; }
    if (lane < 16) ss[lane] = (lane == 0) ? s : 0.f;
}

DI void mix_ac_item(const Args& a, int l, int item, int tid) {
    const bf16_t* Z1 = (const bf16_t*)(a.ws + WS_Z1); bf16_t* OA = (bf16_t*)(a.ws + WS_OUTS); bf16_t* OC = OA + (size_t)2 * MROWS * 512;
    const float* cw = a.in[3] + (size_t)l * 3 * 512;
    const int m0 = item * 64, ch = tid & 63, c0 = ch * 8, tk0 = tid >> 6;
    const u32x4 Z4 = (u32x4){0u, 0u, 0u, 0u};
    f32x4 w[3][2];
#pragma unroll
    for (int j = 0; j < 3; ++j) { w[j][0] = *(const f32x4*)(cw + j * 512 + c0); w[j][1] = *(const f32x4*)(cw + j * 512 + c0 + 4); }
    for (int b4 = 0; b4 < 2; ++b4) { u32x4 ab[4], cc[4][3], xx[4][3];
#pragma unroll
        for (int t = 0; t < 4; ++t) { const int m = m0 + tk0 + 8 * (4 * b4 + t), tt = m & (SEQ - 1); const bf16_t* zr = Z1 + (size_t)m * ZP; ab[t] = *(const u32x4*)(zr + C_AB + c0);
#pragma unroll
            for (int j = 0; j < 3; ++j) { cc[t][j] = Z4; xx[t][j] = Z4; if (tt - 2 + j >= 0) { const bf16_t* zs = zr - (size_t)(2 - j) * ZP; cc[t][j] = *(const u32x4*)(zs + C_AC + c0); xx[t][j] = *(const u32x4*)(zs + C_AX + c0); } } }
#pragma unroll
        for (int t = 0; t < 4; ++t) { const int m = m0 + tk0 + 8 * (4 * b4 + t); float abf[8], acc[8]; unpack8(ab[t], abf);
#pragma unroll
            for (int e = 0; e < 8; ++e) acc[e] = 0.f;
#pragma unroll
            for (int j = 0; j < 3; ++j) { float c_[8], x_[8]; unpack8(cc[t][j], c_); unpack8(xx[t][j], x_);
#pragma unroll
                for (int e = 0; e < 4; ++e) { acc[e] += w[j][0][e] * (c_[e] * x_[e]); acc[4 + e] += w[j][1][e] * (c_[4 + e] * x_[4 + e]); } }
#pragma unroll
            for (int e = 0; e < 8; ++e) acc[e] *= abf[e];
            *(u32x4*)(OA + (size_t)m * 512 + c0) = pack8(acc); } }
    const int gi = ch >> 4, wn = 2 << gi;
    for (int b2 = 0; b2 < 4; ++b2) { u32x4 pq[2][16];
#pragma unroll
        for (int t = 0; t < 2; ++t) { const int m = m0 + tk0 + 8 * (2 * b2 + t), tt = m & (SEQ - 1); const bf16_t* zr = Z1 + (size_t)m * ZP; const int nb = (tt + 1 < wn) ? tt + 1 : wn;
#pragma unroll
            for (int i = 0; i < 16; ++i) { pq[t][i] = Z4; if (i < nb) pq[t][i] = *(const u32x4*)(zr - (size_t)i * ZP + C_PL + c0); } }
#pragma unroll
        for (int t = 0; t < 2; ++t) { const int m = m0 + tk0 + 8 * (2 * b2 + t), tt = m & (SEQ - 1); const int nb = (tt + 1 < wn) ? tt + 1 : wn; float p0[8], sm[8]; unpack8(pq[t][0], p0);
#pragma unroll
            for (int e = 0; e < 8; ++e) sm[e] = p0[e];
#pragma unroll
            for (int i = 1; i < 16; ++i) { float q[8]; unpack8(pq[t][i], q);
#pragma unroll
                for (int e = 0; e < 8; ++e) sm[e] += q[e]; }
            const float inv = 1.0f / (float)nb;
#pragma unroll
            for (int e = 0; e < 8; ++e) sm[e] = sm[e] * inv - p0[e];
            *(u32x4*)(OC + (size_t)m * 512 + c0) = pack8(sm); } }
}
DI float gelu_erf(float v) {
    const float av = fabsf(v), t = __builtin_amdgcn_rcpf(av * 0.2316418882f + 1.0f);
    float q = t * 0.5307027145f + (-0.7265760135f); q = q * t + 0.7107068705f; q = q * t + (-0.142248368f); q = q * t + 0.127414796f; q = q * t;
    const float e = __builtin_amdgcn_exp2f((v * v) * (-0.72134752044f)); const float m = v * (q * e);
    return v < 0.f ? m : v - m;
}
DI void sgu_item(const Args& a, int l, int item, unsigned char* lds, int tid) {
    const bf16_t* Z1 = (const bf16_t*)(a.ws + WS_Z1); bf16_t* OD = (bf16_t*)(a.ws + WS_OUTS) + (size_t)3 * MROWS * 512;
    const float* ng = a.in[10] + l * 512; const float* sw = a.in[11] + (size_t)l * 4 * 128 * 128; const float* sb = a.in[12] + l * 4 * 128;
    constexpr int VP = 136;
    bf16_t* vT = (bf16_t*)lds; const int m0 = item * 128, lane = tid & 63, wave = __builtin_amdgcn_readfirstlane(tid >> 6);
    float ngv[8];
#pragma unroll
    for (int e = 0; e < 8; ++e) ngv[e] = ng[e * 64 + lane];
    for (int s4 = 0; s4 < 4; ++s4) {
        bf16_t raw[4][8];
#pragma unroll
        for (int rr = 0; rr < 4; ++rr) { const bf16_t* zr = Z1 + (size_t)(m0 + wave + 8 * (4 * s4 + rr)) * ZP + C_SG + 512 + lane;
#pragma unroll
            for (int e = 0; e < 8; ++e) raw[rr][e] = zr[e * 64]; }
#pragma unroll
        for (int rr = 0; rr < 4; ++rr) { const int s = wave + 8 * (4 * s4 + rr); float v[8]; float q = 0.f;
#pragma unroll
            for (int e = 0; e < 8; ++e) { v[e] = gelu_erf(bf1(raw[rr][e])); q += v[e] * v[e]; }
            q = wave_sum(q); const float rs = rsqrtf(q * (1.0f / 512.0f) + 1e-6f);
#pragma unroll
            for (int e = 0; e < 8; ++e) vT[(size_t)(e * 64 + lane) * VP + s] = f2bf(v[e] * rs * ngv[e]); }
    }
    __syncthreads();
    const int g = wave >> 1, hw = wave & 1, rl = lane & 31, h = lane >> 5;
    for (int q2 = 0; q2 < 2; ++q2) { const int tt = (q2 == 0) ? (hw ? 1 : 0) : (hw ? 2 : 3); const int t = 32 * tt + rl;
        f32x16 acc[4];
#pragma unroll
        for (int ct = 0; ct < 4; ++ct)
#pragma unroll
            for (int i = 0; i < 16; ++i) acc[ct][i] = 0.f;
        const float* wrow = sw + ((size_t)g * 128 + t) * 128;
        f32x4 wq[8][2];
#pragma unroll
        for (int ks = 0; ks < 8; ++ks) { const int s0 = 16 * ks + 8 * h; if (ks < 2 * (tt + 1)) { wq[ks][0] = *(const f32x4*)(wrow + s0); wq[ks][1] = *(const f32x4*)(wrow + s0 + 4); } else { wq[ks][0] = (f32x4){0.f, 0.f, 0.f, 0.f}; wq[ks][1] = (f32x4){0.f, 0.f, 0.f, 0.f}; } }
#pragma unroll
        for (int ks = 0; ks < 8; ++ks) { if (ks < 2 * (tt + 1)) { const int s0 = 16 * ks + 8 * h; f32x4 w0 = wq[ks][0], w1 = wq[ks][1];
#pragma unroll
            for (int e = 0; e < 4; ++e) { if (s0 + e > t) w0[e] = 0.f; if (s0 + 4 + e > t) w1[e] = 0.f; }
            u32x4 wp; wp.x = cvtpk(w0[0], w0[1]); wp.y = cvtpk(w0[2], w0[3]); wp.z = cvtpk(w1[0], w1[1]); wp.w = cvtpk(w1[2], w1[3]); const bf16x8 af = __builtin_bit_cast(bf16x8, wp);
#pragma unroll
            for (int ct = 0; ct < 4; ++ct) { const bf16x8 bfr = *(const bf16x8*)(vT + (size_t)(g * 128 + ct * 32 + rl) * VP + s0); acc[ct] = __builtin_amdgcn_mfma_f32_32x32x16_bf16(af, bfr, acc[ct], 0, 0, 0); } } }
#pragma unroll
        for (int ct = 0; ct < 4; ++ct) { const int c = g * 128 + ct * 32 + rl; bf16_t ur[16];
#pragma unroll
            for (int i = 0; i < 16; ++i) { const int tr = 32 * tt + (i & 3) + 8 * (i >> 2) + 4 * h; ur[i] = Z1[(size_t)(m0 + tr) * ZP + C_SG + c]; }
#pragma unroll
            for (int i = 0; i < 16; ++i) { const int tr = 32 * tt + (i & 3) + 8 * (i >> 2) + 4 * h; const float u = gelu_erf(bf1(ur[i]));
                OD[(size_t)(m0 + tr) * 512 + c] = f2bf(u * (acc[ct][i] + sb[g * 128 + tr])); } }
    }
    __syncthreads();
}
DI void prep_item(const Args& a, int l, int item, unsigned char* lds, int tid) {
    bf16_t* Z1 = (bf16_t*)(a.ws + WS_Z1); bf16_t* VT = (bf16_t*)(a.ws + WS_VT); const float* qg = a.in[4] + (size_t)l * 4 * 64;
    const int m0 = item * 64;
    { u32x4 raw[4];
#pragma unroll
      for (int it = 0; it < 4; ++it) { const int idx = tid + 512 * it, vec = idx >> 3, part = idx & 7, tok = vec >> 2, kind = (vec >> 1) & 1, g = vec & 1; raw[it] = *(const u32x4*)(Z1 + (size_t)(m0 + tok) * ZP + C_KV + (2 + 2 * kind) * 128 + g * 64 + part * 8); }
#pragma unroll
      for (int it = 0; it < 4; ++it) { const int idx = tid + 512 * it, vec = idx >> 3, part = idx & 7, tok = vec >> 2, kind = (vec >> 1) & 1, g = vec & 1;
        bf16_t* p = Z1 + (size_t)(m0 + tok) * ZP + C_KV + (2 + 2 * kind) * 128 + g * 64 + part * 8; float v[8]; unpack8(raw[it], v); float q = 0.f;
#pragma unroll
        for (int e = 0; e < 8; ++e) q += v[e] * v[e];
        q += __shfl_xor(q, 1); q += __shfl_xor(q, 2); q += __shfl_xor(q, 4); const float rs = rsqrtf(q * (1.0f / 64.0f) + 1e-6f); const float* gw = qg + (2 + kind) * 64 + part * 8;
#pragma unroll
        for (int e = 0; e < 8; ++e) v[e] = v[e] * rs * gw[e];
        *(u32x4*)p = pack8(v); } }
    bf16_t* tl = (bf16_t*)lds;
    { const int tok = tid >> 3, part = tid & 7;
#pragma unroll
      for (int t4 = 0; t4 < 4; ++t4) { const int kind = t4 >> 1, g = t4 & 1;
        *(u32x4*)(tl + t4 * 64 * 72 + tok * 72 + part * 8) = *(const u32x4*)(Z1 + (size_t)(m0 + tok) * ZP + C_KV + (3 + 2 * kind) * 128 + g * 64 + part * 8); } }
    __syncthreads();
    { const int chunk = tid & 7, d = tid >> 3, b = m0 >> 12, tt0 = m0 & (SEQ - 1);
#pragma unroll
      for (int t4 = 0; t4 < 4; ++t4) { const int kind = t4 >> 1, g = t4 & 1; const bf16_t* s = tl + t4 * 64 * 72 + (chunk * 8) * 72 + d;
        u32x4 o; o.x = (unsigned)s[0] | ((unsigned)s[72] << 16); o.y = (unsigned)s[2 * 72] | ((unsigned)s[3 * 72] << 16); o.z = (unsigned)s[4 * 72] | ((unsigned)s[5 * 72] << 16); o.w = (unsigned)s[6 * 72] | ((unsigned)s[7 * 72] << 16);
        *(u32x4*)(VT + ((((size_t)kind * NB + b) * 2 + g) * 64 + d) * SEQ + tt0 + chunk * 8) = o; } }
    __syncthreads();
}
DI void compress_item(const Args& a, int l, int item, unsigned char* lds, int tid) {
    const bf16_t* Z1 = (const bf16_t*)(a.ws + WS_Z1); bf16_t* KC = (bf16_t*)(a.ws + WS_KC); bf16_t* VCT = (bf16_t*)(a.ws + WS_VCT); const bf16_t* W1T = (const bf16_t*)(a.ws + WS_W1T);
    const int lane = tid & 63, wave = __builtin_amdgcn_readfirstlane(tid >> 6);
    const int tix = item % 17, r3 = item / 17, j = r3 & 1, g = (r3 >> 1) & 1, b = r3 >> 2;
    const float* pe = a.in[5] + ((size_t)l * 2 + j) * 2048; const float* w2 = a.in[7] + ((size_t)l * 2 + j) * 64 * 64; const float* g1 = a.in[4] + (size_t)l * 4 * 64 + 64;
    const int r = lane & 15, kq = lane >> 4, n = 15 * tix + r;
    const bf16_t* arow = Z1 + ((size_t)b * SEQ + 16 * n) * ZP + C_KV + j * 128 + g * 64;
    const bf16_t* wrow = W1T + (size_t)j * 64 * 2048 + (size_t)r * 2048;
    float* part = (float*)lds; float* hs = (float*)(lds + 32768);
    pg8::f32x4 acc[4];
#pragma unroll
    for (int ct = 0; ct < 4; ++ct) acc[ct] = (pg8::f32x4){0.f, 0.f, 0.f, 0.f};
#pragma unroll
    for (int ks = 0; ks < 8; ++ks) { const int kk = wave * 256 + ks * 32 + kq * 8, li = kk >> 6, d0 = kk & 63; bf16x8 af;
        if (r < 15) af = *(const bf16x8*)(arow + (size_t)li * ZP + d0);
        else { const f32x4 p0 = *(const f32x4*)(pe + kk), p1 = *(const f32x4*)(pe + kk + 4); u32x4 w; w.x = cvtpk(p0[0], p0[1]); w.y = cvtpk(p0[2], p0[3]); w.z = cvtpk(p1[0], p1[1]); w.w = cvtpk(p1[2], p1[3]); af = __builtin_bit_cast(bf16x8, w); }
#pragma unroll
        for (int ct = 0; ct < 4; ++ct) { const bf16x8 bfr = *(const bf16x8*)(wrow + (size_t)ct * 16 * 2048 + kk); acc[ct] = __builtin_amdgcn_mfma_f32_16x16x32_bf16(af, bfr, acc[ct], 0, 0, 0); } }
#pragma unroll
    for (int ct = 0; ct < 4; ++ct)
#pragma unroll
        for (int i = 0; i < 4; ++i) part[wave * 1024 + (4 * kq + i) * 64 + ct * 16 + r] = acc[ct][i];
    __syncthreads();
    { float s0 = 0.f, s1 = 0.f;
#pragma unroll
      for (int w = 0; w < 8; ++w) { s0 += part[w * 1024 + tid]; s1 += part[w * 1024 + 512 + tid]; }
      hs[tid] = s0; hs[512 + tid] = s1; }
    __syncthreads();
    { const float b0 = hs[15 * 64 + (tid & 63)]; const float x0 = hs[tid] + b0, x1 = hs[512 + tid] + b0;
      __syncthreads();
      hs[tid] = x0 / (1.0f + __expf(-x0)); hs[512 + tid] = x1 / (1.0f + __expf(-x1)); }
    __syncthreads();
    { const int r0 = wave, r1 = wave + 8; float o0 = 0.f, o1 = 0.f;
#pragma unroll
      for (int k16 = 0; k16 < 4; ++k16) { float wv[16];
#pragma unroll
          for (int k = 0; k < 16; ++k) wv[k] = w2[(k16 * 16 + k) * 64 + lane];
#pragma unroll
          for (int k = 0; k < 16; ++k) { o0 += hs[r0 * 64 + k16 * 16 + k] * wv[k]; o1 += hs[r1 * 64 + k16 * 16 + k] * wv[k]; } }
      if (j == 0) { const float gg = g1[lane];
          { const float q = wave_sum(o0 * o0); KC[(((size_t)b * 2 + g) * 256 + 15 * tix + r0) * 64 + lane] = f2bf(o0 * rsqrtf(q * (1.0f / 64.0f) + 1e-6f) * gg); }
          { const float q = wave_sum(o1 * o1); if (r1 < 15) KC[(((size_t)b * 2 + g) * 256 + 15 * tix + r1) * 64 + lane] = f2bf(o1 * rsqrtf(q * (1.0f / 64.0f) + 1e-6f) * gg); }
          if (tix == 16 && wave == 0) KC[(((size_t)b * 2 + g) * 256 + 255) * 64 + lane] = 0;
      } else {
          VCT[(((size_t)b * 2 + g) * 64 + lane) * 256 + 15 * tix + r0] = f2bf(o0);
          if (r1 < 15) VCT[(((size_t)b * 2 + g) * 64 + lane) * 256 + 15 * tix + r1] = f2bf(o1);
          if (tix == 16 && wave == 0) VCT[(((size_t)b * 2 + g) * 64 + lane) * 256 + 255] = 0;
      } }
    __syncthreads();
}
DI void act_fixup(const Args& a, int l, int gtid, int ngt) {
    bf16_t* ACT = (bf16_t*)(a.ws + WS_Z1); const float* sb = (const float*)(a.ws + WS_SB); const float* cw = a.in[17] + (size_t)l * 3 * DFF;
    for (int idx = gtid; idx < 128 * 2 * DFF; idx += ngt) { const int c = idx % DFF, rr = idx / DFF, r = rr & 1, pm = rr >> 1, row = pm * 256 + r, tt = row & (SEQ - 1);
        const float g0 = sb[((size_t)(1 * 128 + pm) * 2 + r) * DFF + c], up = sb[((size_t)(2 * 128 + pm) * 2 + r) * DFF + c];
        const int pmm = pm > 0 ? pm - 1 : 0;
        const float last1 = sb[((size_t)(0 * 128 + pmm) * 2 + 1) * DFF + c], last0 = sb[((size_t)(0 * 128 + pmm) * 2 + 0) * DFF + c];
        float g1, g2;
        if (r == 1) { g1 = sb[((size_t)(1 * 128 + pm) * 2 + 0) * DFF + c]; g2 = tt >= 2 ? last1 : 0.f; }
        else { g1 = tt >= 1 ? last1 : 0.f; g2 = tt >= 2 ? last0 : 0.f; }
        const float cv = cw[c] * g2 + cw[DFF + c] * g1 + cw[2 * DFF + c] * g0;
        ACT[(size_t)row * DFF + c] = f2bf(cv / (1.0f + __expf(-cv)) * up); }
}
#define MFMA32(a, b, c) __builtin_amdgcn_mfma_f32_32x32x16_bf16((a), (b), (c), 0, 0, 0)
constexpr int NRT = 1, NTOK = 8 * NRT, LPT = 64 / NTOK, CPL = 64 / LPT;
struct AttnSt { f32x16 o[2][NRT]; float l[NRT]; };
DI int crow(int i, int h) { return (i & 3) + 8 * (i >> 2) + 4 * h; }
DI void attn_reset(AttnSt& st) {
#pragma unroll
    for (int dt = 0; dt < 2; ++dt)
#pragma unroll
        for (int rt = 0; rt < NRT; ++rt)
#pragma unroll
            for (int i = 0; i < 16; ++i) st.o[dt][rt][i] = 0.f;
    for (int rt = 0; rt < NRT; ++rt) st.l[rt] = 0.f; }
struct KV { bf16x8 kf[4]; s16x4 v[2][2][2]; };
DI void kv_load(KV& f, const bf16_t* kp, const bf16_t* vp, size_t vpitch) {
#pragma unroll
    for (int dc = 0; dc < 4; ++dc) f.kf[dc] = *(const bf16x8*)(kp + dc * 16);
#pragma unroll
    for (int dt = 0; dt < 2; ++dt)
#pragma unroll
        for (int sx = 0; sx < 2; ++sx) { const bf16_t* q = vp + (size_t)dt * 32 * vpitch + 16 * sx; f.v[dt][sx][0] = *(const s16x4*)q; f.v[dt][sx][1] = *(const s16x4*)(q + 8); }
}
DI void kv_copy(KV& d, const KV& s_) {
#pragma unroll
    for (int dc = 0; dc < 4; ++dc) d.kf[dc] = s_.kf[dc];
#pragma unroll
    for (int dt = 0; dt < 2; ++dt)
#pragma unroll
        for (int sx = 0; sx < 2; ++sx) { d.v[dt][sx][0] = s_.v[dt][sx][0]; d.v[dt][sx][1] = s_.v[dt][sx][1]; }
}
DI void attn_scores(f32x16 (&s)[NRT], const bf16x8 (&qf)[NRT][4], const KV& f) {
#pragma unroll
    for (int rt = 0; rt < NRT; ++rt) { f32x16 z;
#pragma unroll
        for (int i = 0; i < 16; ++i) z[i] = 0.f;
#pragma unroll
        for (int dc = 0; dc < 4; ++dc) z = MFMA32(f.kf[dc], qf[rt][dc], z);
        s[rt] = z; }
}
DI void attn_softmax(AttnSt& st, f32x16 (&s)[NRT], float cref, bool rowon) {
#pragma unroll
    for (int rt = 0; rt < NRT; ++rt) { float ps = 0.f;
        if (cref != 0.f) {
#pragma unroll
            for (int i = 0; i < 16; ++i) s[rt][i] -= cref; }
#pragma unroll
        for (int i = 0; i < 16; ++i) { const float p = __builtin_amdgcn_exp2f(s[rt][i]); s[rt][i] = p; ps += p; }
        st.l[rt] += rowon ? ps : 0.f; }
}
DI void attn_pv(AttnSt& st, const f32x16 (&p)[NRT], const KV& f, bool rowon) {
    bf16x8 pf[NRT][2];
#pragma unroll
    for (int rt = 0; rt < NRT; ++rt)
#pragma unroll
        for (int sx = 0; sx < 2; ++sx) { u32x4 w; w.x = cvtpk(p[rt][8 * sx], p[rt][8 * sx + 1]); w.y = cvtpk(p[rt][8 * sx + 2], p[rt][8 * sx + 3]); w.z = cvtpk(p[rt][8 * sx + 4], p[rt][8 * sx + 5]); w.w = cvtpk(p[rt][8 * sx + 6], p[rt][8 * sx + 7]); if (!rowon) { w.x = 0u; w.y = 0u; w.z = 0u; w.w = 0u; } pf[rt][sx] = __builtin_bit_cast(bf16x8, w); }
#pragma unroll
    for (int dt = 0; dt < 2; ++dt)
#pragma unroll
        for (int rt = 0; rt < NRT; ++rt)
#pragma unroll
            for (int sx = 0; sx < 2; ++sx) { const bf16x8 vf = __builtin_shufflevector(f.v[dt][sx][0], f.v[dt][sx][1], 0, 1, 2, 3, 4, 5, 6, 7); st.o[dt][rt] = MFMA32(vf, pf[rt][sx], st.o[dt][rt]); }
}
template <bool FIRST> DI void attn_flush(const AttnSt& st, const float (&sc)[NRT], bf16_t* const (&orow)[NRT]) {
#pragma unroll
    for (int rt = 0; rt < NRT; ++rt) { u32x2 old[2][4];
        if (!FIRST) {
#pragma unroll
            for (int dt = 0; dt < 2; ++dt)
#pragma unroll
                for (int q4 = 0; q4 < 4; ++q4) old[dt][q4] = *(const u32x2*)(orow[rt] + dt * 32 + 8 * q4); }
#pragma unroll
        for (int dt = 0; dt < 2; ++dt)
#pragma unroll
            for (int q4 = 0; q4 < 4; ++q4) { u32x2* p = (u32x2*)(orow[rt] + dt * 32 + 8 * q4); float v0 = st.o[dt][rt][4 * q4] * sc[rt], v1 = st.o[dt][rt][4 * q4 + 1] * sc[rt], v2 = st.o[dt][rt][4 * q4 + 2] * sc[rt], v3 = st.o[dt][rt][4 * q4 + 3] * sc[rt];
                if (!FIRST) { v0 += bflo(old[dt][q4].x); v1 += bfhi(old[dt][q4].x); v2 += bflo(old[dt][q4].y); v3 += bfhi(old[dt][q4].y); }
                u32x2 w; w.x = cvtpk(v0, v1); w.y = cvtpk(v2, v3); *p = w; } }
}
typedef const __attribute__((address_space(3))) unsigned char* LP;
DI void kv_load_lds(KV& f, LP kp, LP vp, int vpitch_b) {
#pragma unroll
    for (int dc = 0; dc < 4; ++dc) f.kf[dc] = *(const __attribute__((address_space(3))) bf16x8*)(kp + dc * 32);
#pragma unroll
    for (int dt = 0; dt < 2; ++dt)
#pragma unroll
        for (int sx = 0; sx < 2; ++sx) { LP q = vp + dt * 32 * vpitch_b + 32 * sx; f.v[dt][sx][0] = *(const __attribute__((address_space(3))) s16x4*)q; f.v[dt][sx][1] = *(const __attribute__((address_space(3))) s16x4*)(q + 16); }
}
struct MaskCausal { int tk; DI bool operator()(int kp) const { return kp <= tk; } };
struct MaskWindow { int tk; DI bool operator()(int kp) const { return kp <= tk && kp > tk - 512; } };
template <class M> DI void attn_block64(AttnSt& st, const bf16x8 (&qf)[NRT][4], LP kt, LP vt, int kpb, int vpb, float cref, bool rowon, bool domask, const M mk, int kbase, int h) {
    KV f0, f1;
#pragma unroll
    for (int dc = 0; dc < 4; ++dc) { f0.kf[dc] = *(const __attribute__((address_space(3))) bf16x8*)(kt + dc * 32); f1.kf[dc] = *(const __attribute__((address_space(3))) bf16x8*)(kt + 32 * kpb + dc * 32); }
    f32x16 s0[NRT], s1[NRT]; attn_scores(s0, qf, f0); attn_scores(s1, qf, f1);
    __builtin_amdgcn_sched_barrier(0);
#pragma unroll
    for (int dt = 0; dt < 2; ++dt)
#pragma unroll
        for (int sx = 0; sx < 2; ++sx) { LP q = vt + dt * 32 * vpb + 32 * sx; f0.v[dt][sx][0] = *(const __attribute__((address_space(3))) s16x4*)q; f0.v[dt][sx][1] = *(const __attribute__((address_space(3))) s16x4*)(q + 16);
            f1.v[dt][sx][0] = *(const __attribute__((address_space(3))) s16x4*)(q + 64); f1.v[dt][sx][1] = *(const __attribute__((address_space(3))) s16x4*)(q + 80); }
    if (domask) {
#pragma unroll
        for (int i = 0; i < 16; ++i) { if (!mk(kbase + crow(i, h))) s0[0][i] = -INFINITY; if (!mk(kbase + 32 + crow(i, h))) s1[0][i] = -INFINITY; } }
    if (cref != 0.f) {
#pragma unroll
        for (int i = 0; i < 16; ++i) { s0[0][i] -= cref; s1[0][i] -= cref; } }
    float ps0 = 0.f, ps1 = 0.f;
#pragma unroll
    for (int i = 0; i < 16; ++i) { const float p0 = __builtin_amdgcn_exp2f(s0[0][i]); s0[0][i] = p0; ps0 += p0; }
    attn_pv(st, s0, f0, rowon);
#pragma unroll
    for (int i = 0; i < 16; ++i) { const float p1 = __builtin_amdgcn_exp2f(s1[0][i]); s1[0][i] = p1; ps1 += p1; }
    st.l[0] += rowon ? (ps0 + ps1) : 0.f;
    attn_pv(st, s1, f1, rowon);
}
constexpr int AL_KC = 0, KC_PB = 144, AL_VC = 36864, VC_PB = 520, AL_KR = AL_VC + 64 * VC_PB, KR_PB = 144, KR_SZ = 64 * KR_PB, AL_VR = AL_KR + 2 * KR_SZ, VR_PB = 136, VR_SZ = 64 * VR_PB, AL_WT = AL_VR + 2 * VR_SZ, WT_SZ = 4224, AL_UW = AL_WT + 8 * WT_SZ;
static_assert(AL_UW + 64 <= LDS_BYTES - 64, "attention LDS map");
DI void nsa_wg_unit(const Args& a, int l, int b, int g, int tb, unsigned char* lds, int tid_in, bool stage) {
    int tid = tid_in; asm volatile("" : "+v"(tid));
    const int lane = tid & 63, wave = __builtin_amdgcn_readfirstlane(tid >> 6);
    const bf16_t* Z1 = (const bf16_t*)(a.ws + WS_Z1);
    const bf16_t* KC = (const bf16_t*)(a.ws + WS_KC) + ((size_t)b * 2 + g) * 256 * 64; const bf16_t* VCT = (const bf16_t*)(a.ws + WS_VCT) + ((size_t)b * 2 + g) * 64 * 256;
    const bf16_t* VST = (const bf16_t*)(a.ws + WS_VT) + (((size_t)0 * NB + b) * 2 + g) * 64 * SEQ; const bf16_t* VWT = (const bf16_t*)(a.ws + WS_VT) + (((size_t)1 * NB + b) * 2 + g) * 64 * SEQ;
    bf16_t* OB = (bf16_t*)(a.ws + WS_OUTS) + (size_t)MROWS * 512;
    const int rl = lane & 31, h = lane >> 5, head = rl & 3, t0 = tb * 64 + wave * 8, jt = tb;
    int tk[NRT]; tk[0] = t0 + (rl >> 2);
    const bf16_t* zb = Z1 + (size_t)b * SEQ * ZP;
    LP L = (LP)lds;
    __syncthreads();
    if (stage) {
    for (int i = tid; i < 2048; i += 512) { const int row = i >> 3, ch = i & 7; *(u32x4*)(lds + AL_KC + row * KC_PB + ch * 16) = *(const u32x4*)(KC + row * 64 + ch * 8); }
    for (int i = tid; i < 2048; i += 512) { const int row = i >> 5, ch = i & 31; const u32x4 v = *(const u32x4*)(VCT + row * 256 + ch * 8); u32x2* d = (u32x2*)(lds + AL_VC + row * VC_PB + ch * 16); u32x2 lo, hi; lo.x = v.x; lo.y = v.y; hi.x = v.z; hi.y = v.w; d[0] = lo; d[1] = hi; }
    }
    bf16x8 qf[NRT][4]; float gt[NRT][3]; bf16_t* orow[NRT];
    { const bf16_t* zr = zb + (size_t)tk[0] * ZP;
#pragma unroll
      for (int dc = 0; dc < 4; ++dc) qf[0][dc] = *(const bf16x8*)(zr + C_Q + (g * 4 + head) * 64 + dc * 16 + 8 * h);
      { const float* qg = a.in[4] + (size_t)l * 4 * 64; float qv[4][8]; float qs = 0.f;
#pragma unroll
        for (int dc = 0; dc < 4; ++dc) { unpack8(__builtin_bit_cast(u32x4, qf[0][dc]), qv[dc]);
#pragma unroll
            for (int e = 0; e < 8; ++e) qs += qv[dc][e] * qv[dc][e]; }
        qs += __shfl_xor(qs, 32); const float rs = rsqrtf(qs * (1.0f / 64.0f) + 1e-6f) * QSC;
#pragma unroll
        for (int dc = 0; dc < 4; ++dc) { const f32x4 g0 = *(const f32x4*)(qg + dc * 16 + 8 * h), g1 = *(const f32x4*)(qg + dc * 16 + 8 * h + 4);
#pragma unroll
            for (int e = 0; e < 4; ++e) { qv[dc][e] = qv[dc][e] * rs * g0[e]; qv[dc][4 + e] = qv[dc][4 + e] * rs * g1[e]; }
            qf[0][dc] = __builtin_bit_cast(bf16x8, pack8(qv[dc])); } }
#pragma unroll
      for (int br = 0; br < 3; ++br) gt[0][br] = 1.0f / (1.0f + __expf(-bf1(zr[C_NG + (g * 4 + head) * 3 + br])));
      orow[0] = OB + ((size_t)b * SEQ + tk[0]) * 512 + (g * 4 + head) * 64 + 4 * h; }
    float cref[3];
    { const float* qg = a.in[4] + (size_t)l * 4 * 64; float mx[4];
#pragma unroll
      for (int k4 = 0; k4 < 4; ++k4) { float v = fabsf(qg[k4 * 64 + lane]);
#pragma unroll
          for (int o = 1; o < 64; o <<= 1) v = fmaxf(v, __shfl_xor(v, o));
          mx[k4] = v; }
#pragma unroll
      for (int br = 0; br < 3; ++br) { const float bnd = 64.0f * QSC * mx[0] * mx[1 + br]; cref[br] = bnd > 64.0f ? bnd : 0.f; } }
    float* wl = (float*)(lds + AL_WT + wave * WT_SZ); float* IA = wl; float* IB = wl + NTOK * 65;
    for (int i = lane; i < 2 * NTOK * 65; i += 64) wl[i] = 0.f;
    __syncthreads();
    AttnSt st;
    int nv[NRT]; nv[0] = tk[0] >= 31 ? ((tk[0] - 31) >> 4) + 1 : 0;
    const int nvmax = (t0 + NTOK - 1 >= 31) ? ((t0 + NTOK - 1 - 31) >> 4) + 1 : 0, nst = (nvmax + 31) >> 5;
    st.l[0] = 0.f;
    const LP kcl = L + AL_KC + rl * KC_PB + 16 * h, vcl = L + AL_VC + rl * VC_PB + 8 * h;
    for (int T = 0; T < nst; ++T) { f32x16 s[NRT]; KV f; kv_load_lds(f, kcl + 32 * T * KC_PB, vcl + 64 * T, VC_PB); attn_scores(s, qf, f); float ps = 0.f;
#pragma unroll
        for (int i = 0; i < 16; ++i) { const float sv = (32 * T + crow(i, h) >= nv[0]) ? -INFINITY : s[0][i] - cref[0]; ps += __builtin_amdgcn_exp2f(sv); }
        st.l[0] += ps; }
    float mu2, inv;
    { const float lt = st.l[0] + __shfl_xor(st.l[0], 32); inv = lt > 0.f ? 1.0f / lt : 0.f; mu2 = cref[0]; }
    attn_reset(st);
    for (int T = 0; T < nst; ++T) { f32x16 s[NRT]; KV f; kv_load_lds(f, kcl + 32 * T * KC_PB, vcl + 64 * T, VC_PB); attn_scores(s, qf, f);
#pragma unroll
        for (int i = 0; i < 16; ++i) { const float p = __builtin_amdgcn_exp2f(s[0][i] - mu2) * inv; s[0][i] = (32 * T + crow(i, h) >= nv[0]) ? 0.f : p; }
#pragma unroll
        for (int q4 = 0; q4 < 4; ++q4) { float p3 = 0.5f * s[0][4 * q4 + 3]; float av = (s[0][4 * q4] + s[0][4 * q4 + 1]) + (s[0][4 * q4 + 2] + p3);
            av += __shfl_xor(av, 1); av += __shfl_xor(av, 2); p3 += __shfl_xor(p3, 1); p3 += __shfl_xor(p3, 2);
            if (head == 0) { const int j = 8 * T + 2 * q4 + h, tok16 = (rl >> 2); IA[tok16 * 65 + j] = av; if (j + 1 < 64) IB[tok16 * 65 + j + 1] = p3; } }
        attn_pv(st, s, f, true); }
    { float sc[NRT]; sc[0] = gt[0][0]; attn_flush<true>(st, sc, orow); }
    LDS_FENCE();
    unsigned sel_lo[NRT], sel_hi[NRT], ulo, uhi;
    { const int tok = lane / LPT, qtr = lane % LPT; float mv[CPL];
#pragma unroll
      for (int c = 0; c < CPL; ++c) { const int j = qtr * CPL + c; float v = IA[tok * 65 + j] + IB[tok * 65 + j]; const bool forced = (j == 0) | (j == jt) | (j == jt - 1); v = forced ? 1e6f : (j > jt ? -1e30f : v); mv[c] = v; }
      LDS_FENCE();
#pragma unroll
      for (int c = 0; c < CPL; ++c) IA[tok * 65 + qtr * CPL + c] = mv[c];
      LDS_FENCE();
      int cnt[CPL];
#pragma unroll
      for (int c = 0; c < CPL; ++c) cnt[c] = (qtr * CPL + c <= jt) ? 0 : 64;
      if (jt >= 16)
#pragma unroll 4
      for (int i = 0; i < 64; ++i) { const float vi = IA[tok * 65 + i];
#pragma unroll
          for (int c = 0; c < CPL; ++c) { const int j = qtr * CPL + c; cnt[c] += ((vi > mv[c]) || (vi == mv[c] && i < j)) ? 1 : 0; } }
      unsigned mc = 0;
#pragma unroll
      for (int c = 0; c < CPL; ++c) mc |= (cnt[c] < 16) ? (1u << c) : 0u;
      unsigned lo = 0, hi = 0;
#pragma unroll
      for (int k = 0; k < LPT / 2; ++k) { lo |= (unsigned)__shfl((int)mc, tok * LPT + k) << (CPL * k); hi |= (unsigned)__shfl((int)mc, tok * LPT + LPT / 2 + k) << (CPL * k); }
      { const int src = (rl >> 2) * LPT; sel_lo[0] = (unsigned)__shfl((int)lo, src); sel_hi[0] = (unsigned)__shfl((int)hi, src); }
      unsigned ul = lo, uh = hi;
#pragma unroll
      for (int o = LPT; o < 64; o <<= 1) { ul |= (unsigned)__shfl_xor((int)ul, o); uh |= (unsigned)__shfl_xor((int)uh, o); }
      ulo = (unsigned)__builtin_amdgcn_readfirstlane((int)ul); uhi = (unsigned)__builtin_amdgcn_readfirstlane((int)uh); }
    const unsigned long long myu = ((unsigned long long)uhi << 32) | (unsigned long long)ulo;
    unsigned long long* UW = (unsigned long long*)(lds + AL_UW);
    if (lane == 0) UW[wave] = myu;
    __syncthreads();
    unsigned long long wgu = 0ull;
#pragma unroll
    for (int w = 0; w < 8; ++w) wgu |= UW[w];
    wgu = ((unsigned long long)(unsigned)__builtin_amdgcn_readfirstlane((int)(wgu >> 32)) << 32) | (unsigned long long)(unsigned)__builtin_amdgcn_readfirstlane((int)(unsigned)wgu);
    const int srow = tid >> 3, sch = tid & 7;
    const LP kfl = L + AL_KR + rl * KR_PB + 16 * h, vfl = L + AL_VR + rl * VR_PB + 8 * h;
    attn_reset(st);
    { unsigned long long rem = wgu & ((jt >= 63) ? ~0ull : ((1ull << (jt + 1)) - 1ull));
      const unsigned koff = (unsigned)(srow * ZP + sch * 8) * 2u, voff = (unsigned)(srow * SEQ + sch * 8) * 2u;
      const char* kgb = (const char*)(zb + C_KV + 2 * 128 + g * 64); const char* vgb = (const char*)VST;
      int j = rem ? (int)__builtin_ctzll(rem) : -1, bi = 0; u32x4 kreg, vreg;
      if (j >= 0) { kreg = *(const u32x4*)(kgb + (size_t)(64 * j) * ZP * 2 + koff); vreg = *(const u32x4*)(vgb + (size_t)(64 * j) * 2 + voff);
          *(u32x4*)(lds + AL_KR + srow * KR_PB + sch * 16) = kreg; u32x2* d = (u32x2*)(lds + AL_VR + srow * VR_PB + sch * 16); u32x2 lo2, hi2; lo2.x = vreg.x; lo2.y = vreg.y; hi2.x = vreg.z; hi2.y = vreg.w; d[0] = lo2; d[1] = hi2; }
      __syncthreads();
      while (j >= 0) {
          rem &= rem - 1ull; const int nj = rem ? (int)__builtin_ctzll(rem) : -1;
          if (nj >= 0) { kreg = *(const u32x4*)(kgb + (size_t)(64 * nj) * ZP * 2 + koff); vreg = *(const u32x4*)(vgb + (size_t)(64 * nj) * 2 + voff); }
          if ((myu >> j) & 1ull) {
              const bool on = ((j < 32) ? (sel_lo[0] >> j) & 1u : (sel_hi[0] >> (j - 32)) & 1u) != 0u;
              attn_block64(st, qf, kfl + bi * KR_SZ, vfl + bi * VR_SZ, KR_PB, VR_PB, cref[1], on, j == jt, MaskCausal{tk[0]}, 64 * j, h); }
          if (nj >= 0) { const int nb = bi ^ 1; *(u32x4*)(lds + AL_KR + nb * KR_SZ + srow * KR_PB + sch * 16) = kreg; u32x2* d = (u32x2*)(lds + AL_VR + nb * VR_SZ + srow * VR_PB + sch * 16); u32x2 lo2, hi2; lo2.x = vreg.x; lo2.y = vreg.y; hi2.x = vreg.z; hi2.y = vreg.w; d[0] = lo2; d[1] = hi2; }
          __syncthreads();
          j = nj; bi ^= 1; } }
    { float sc[NRT]; const float lt = st.l[0] + __shfl_xor(st.l[0], 32); sc[0] = lt > 0.f ? gt[0][1] / lt : 0.f; attn_flush<false>(st, sc, orow); }
    attn_reset(st);
    { const unsigned koff = (unsigned)(srow * ZP + sch * 8) * 2u, voff = (unsigned)(srow * SEQ + sch * 8) * 2u; const char* kgb = (const char*)(zb + C_KV + 4 * 128 + g * 64); const char* vgb = (const char*)VWT;
      int j = tb - 8 < 0 ? 0 : tb - 8, bi = 0; u32x4 kreg, vreg;
      { kreg = *(const u32x4*)(kgb + (size_t)(64 * j) * ZP * 2 + koff); vreg = *(const u32x4*)(vgb + (size_t)(64 * j) * 2 + voff);
        *(u32x4*)(lds + AL_KR + srow * KR_PB + sch * 16) = kreg; u32x2* d = (u32x2*)(lds + AL_VR + srow * VR_PB + sch * 16); u32x2 lo2, hi2; lo2.x = vreg.x; lo2.y = vreg.y; hi2.x = vreg.z; hi2.y = vreg.w; d[0] = lo2; d[1] = hi2; }
      __syncthreads();
      for (; j <= tb; ++j) { const bool hn = j + 1 <= tb;
          if (hn) { kreg = *(const u32x4*)(kgb + (size_t)(64 * (j + 1)) * ZP * 2 + koff); vreg = *(const u32x4*)(vgb + (size_t)(64 * (j + 1)) * 2 + voff); }
          if (64 * j + 63 >= t0 - 511 && 64 * j <= t0 + NTOK - 1)
              attn_block64(st, qf, kfl + bi * KR_SZ, vfl + bi * VR_SZ, KR_PB, VR_PB, cref[2], true, (64 * j + 63 > t0) || (64 * j <= t0 + NTOK - 1 - 512), MaskWindow{tk[0]}, 64 * j, h);
          if (hn) { const int nb = bi ^ 1; *(u32x4*)(lds + AL_KR + nb * KR_SZ + srow * KR_PB + sch * 16) = kreg; u32x2* d = (u32x2*)(lds + AL_VR + nb * VR_SZ + srow * VR_PB + sch * 16); u32x2 lo2, hi2; lo2.x = vreg.x; lo2.y = vreg.y; hi2.x = vreg.z; hi2.y = vreg.w; d[0] = lo2; d[1] = hi2; }
          __syncthreads();
          bi ^= 1; } }
    { float sc[NRT]; const float lt = st.l[0] + __shfl_xor(st.l[0], 32); sc[0] = lt > 0.f ? gt[0][2] / lt : 0.f; attn_flush<false>(st, sc, orow); }
}
#define LAS __attribute__((address_space(3)))
constexpr size_t WS_CTL = WS_W1T + 524288;
constexpr size_t CTL_BYTES = 16384;
#define XB_TMO      128
#define XB_XCNT(j)  (256  + 64 * (j))
#define XB_XSUB(j)  (1280 + 64 * (j))
#define XB_XGEN(j)  (2304 + 64 * (j))
#define XB_TOP      3328
#define XB_TOPGEN   3392
#define XCD_BAR_WORDS 3456
#define XB_SPIN_CAP (1u << 18)

__device__ __forceinline__ unsigned xb_ld(unsigned* p)              { return __hip_atomic_load(p, __ATOMIC_RELAXED, __HIP_MEMORY_SCOPE_AGENT); }
__device__ __forceinline__ unsigned xb_add(unsigned* p, unsigned v) { return __hip_atomic_fetch_add(p, v, __ATOMIC_RELAXED, __HIP_MEMORY_SCOPE_AGENT); }
__device__ __forceinline__ unsigned xb_xcc_id() { return (unsigned)__builtin_amdgcn_s_getreg((3 << 11) | 20) & 0xFu; }
#define XB_SPIN(cond, bar) do { unsigned _sp = 0; while (cond) { __builtin_amdgcn_s_sleep(1); \
    if ((++_sp & 255u) == 0u) { if (xb_ld(&(bar)[XB_TMO])) break; if (_sp > XB_SPIN_CAP) { atomicAdd(&(bar)[XB_TMO], 1u); break; } } } } while (0)

struct XcdBarrier {
    unsigned* bar; unsigned x;
    volatile LAS unsigned* st;
};

__device__ __forceinline__ XcdBarrier xcd_barrier_post(unsigned* bar, volatile LAS unsigned* st) {
    XcdBarrier b; b.bar = bar; b.x = xb_xcc_id(); b.st = st;
    if (threadIdx.x == 0) (void)xb_add(&bar[XB_XCNT(b.x)], 1u);
    return b;
}
__device__ __forceinline__ void xcd_barrier_complete(unsigned* bar, unsigned x, unsigned& nloc, unsigned& nx) {
    const unsigned G = gridDim.x * gridDim.y * gridDim.z;
    unsigned sum, cnt, mine, sp = 0u;
    for (;;) {
        sum = 0u; cnt = 0u; mine = 0u;
#pragma unroll
        for (unsigned j = 0; j < 16; ++j) { const unsigned c = xb_ld(&bar[XB_XCNT(j)]); sum += c; cnt += (c > 0u) ? 1u : 0u; mine = (j == x) ? c : mine; }
        if (sum == G) break;
        __builtin_amdgcn_s_sleep(1);
        if ((++sp & 255u) == 0u) { if (xb_ld(&bar[XB_TMO])) break; if (sp > XB_SPIN_CAP) { atomicAdd(&bar[XB_TMO], 1u); break; } }
    }
    nloc = mine > 0u ? mine : 1u; nx = cnt > 0u ? cnt : 1u;
}

__device__ __forceinline__ void xcd_barrier(const XcdBarrier& b) {
    asm volatile("s_waitcnt vmcnt(0)" ::: "memory");
    __syncthreads();
    if (threadIdx.x == 0) {
        unsigned* bar = b.bar;
        __builtin_amdgcn_s_waitcnt(0);
        unsigned nloc = b.st[0], nx = b.st[1];
        if (nloc == 0u) { xcd_barrier_complete(bar, b.x, nloc, nx); b.st[0] = nloc; b.st[1] = nx; }
        const unsigned old = xb_add(&bar[XB_XSUB(b.x)], 1u);
        const unsigned gen = old / nloc;
        if (old + 1u == (gen + 1u) * nloc) {
            __builtin_amdgcn_fence(__ATOMIC_RELEASE, "agent");
            asm volatile("s_waitcnt vmcnt(0)" ::: "memory");
            const unsigned og = xb_add(&bar[XB_TOP], 1u);
            const unsigned tg = og / nx;
            if (og + 1u == (tg + 1u) * nx) xb_add(&bar[XB_TOPGEN], 1u);
            else XB_SPIN(xb_ld(&bar[XB_TOPGEN]) == tg, bar);
            __builtin_amdgcn_fence(__ATOMIC_ACQUIRE, "agent");
            xb_add(&bar[XB_XGEN(b.x)], 1u);
            asm volatile("s_waitcnt vmcnt(0)" ::: "memory");
        } else {
            XB_SPIN(xb_ld(&bar[XB_XGEN(b.x)]) == gen, bar);
            __builtin_amdgcn_fence(__ATOMIC_ACQUIRE, "agent");
            asm volatile("s_waitcnt vmcnt(0)" ::: "memory");
        }
    }
    __syncthreads();
}

constexpr int PPL = 9, N_PHASES = 1 + PPL * DEPTH;
typedef const Args __attribute__((address_space(4)))* KArgP;
DI KArgP launder(KArgP p) { asm volatile("" : "+s"(p)); return p; }
DI Args load_args(KArgP p) { Args a;
#pragma unroll
    for (int i = 0; i < 19; ++i) a.in[i] = p->in[i];
    a.out = p->out; a.ws = p->ws; a.ph_lo = 0; a.ph_hi = 0; a.coop = 0; a.pad = 0; return a; }
__global__ void __launch_bounds__(512, 2) fwd_kernel(Args a_unused) {
    extern __shared__ __attribute__((aligned(16))) unsigned char lds[];
    cg::grid_group grid = cg::this_grid();
    const KArgP kp = (KArgP)__builtin_amdgcn_kernarg_segment_ptr();
    volatile LAS unsigned* bst = (volatile LAS unsigned*)((LAS unsigned char*)lds + (LDS_BYTES - 64));
    if (threadIdx.x < 2) bst[threadIdx.x] = 0u;
    __syncthreads();
    (void)xcd_barrier_post((unsigned*)(kp->ws + WS_CTL), bst);
    const int ph_lo = kp->ph_lo, ph_hi = kp->ph_hi, coop = kp->coop;
#define WSP(T, off) ((T*)(a.ws + (off)))
#define SSA WSP(float, WS_SSA)
#define SSB WSP(float, WS_SSB)
#define XB WSP(bf16_t, WS_XB)
#define Z1 WSP(bf16_t, WS_Z1)
#define OUTS WSP(bf16_t, WS_OUTS)
#define WIN WSP(bf16_t, WS_WIN)
#define WB WSP(bf16_t, WS_WB)
#define WO WSP(bf16_t, WS_WO)
#define WUP WSP(bf16_t, WS_WUP)
#define WDN WSP(bf16_t, WS_WDN)
#define LOD ((bf16_t*)((unsigned char*)a.out + (size_t)MROWS * DM * 2))
#define LOW WSP(bf16_t, WS_Z1 + 192 * MiB)
    for (int p = ph_lo; p < ph_hi; ++p) {
        if (p > ph_lo && coop) { if (p == ph_lo + 1) grid.sync(); else { XcdBarrier b2; b2.bar = (unsigned*)(launder(kp)->ws + WS_CTL); b2.x = xb_xcc_id(); b2.st = (volatile LAS unsigned*)((LAS unsigned char*)lds + (LDS_BYTES - 64)); xcd_barrier(b2); } }
        const Args a = load_args(launder(kp)); int tid = threadIdx.x; asm volatile("" : "+v"(tid)); int G = gridDim.x; asm volatile("" : "+s"(G)); const int bid = blockIdx.x, ngw = G * 8, ngt = G * 512;
        const int lane = tid & 63, wave = __builtin_amdgcn_readfirstlane(tid >> 6), gw = bid * 8 + wave, gtid = bid * 512 + tid; float* scr = (float*)(lds + wave * 8448);
        PG8_LAS unsigned char* glds = (PG8_LAS unsigned char*)lds;
        const int l = (p == 0) ? 0 : (p - 1) / PPL, k = (p == 0) ? -1 : (p - 1) % PPL;
        float* ss1 = SSA; float* ss2 = SSB; float* ss3 = SSA;
        bool is_gemm = false; pg8::Gemm g{nullptr, nullptr, MROWS, 0, 0, 0, 0, 0}; pg8::EpiAny E{0, nullptr, 0, 0, nullptr, nullptr, nullptr, nullptr, nullptr};
        switch (k) {
        case -1:
            for (int m = gw; m < MROWS; m += 2 * ngw) {
                const int m2 = m + ngw; const bool two = m2 < MROWS;
                f32x4 va[4], vb[4];
#pragma unroll
                for (int j = 0; j < 4; ++j) { va[j] = ((const f32x4*)(a.in[0] + (size_t)m * DM) + lane)[64 * j]; vb[j] = two ? ((const f32x4*)(a.in[0] + (size_t)m2 * DM) + lane)[64 * j] : (f32x4){0.f, 0.f, 0.f, 0.f}; }
                float sa = 0.f, sbq = 0.f;
#pragma unroll
                for (int j = 0; j < 4; ++j) { sa += (va[j].x * va[j].x + va[j].y * va[j].y) + (va[j].z * va[j].z + va[j].w * va[j].w); sbq += (vb[j].x * vb[j].x + vb[j].y * vb[j].y) + (vb[j].z * vb[j].z + vb[j].w * vb[j].w); }
                sa = wave_sum(sa); sbq = wave_sum(sbq);
#pragma unroll
                for (int j = 0; j < 4; ++j) { u32x2 w; w.x = cvtpk(va[j].x, va[j].y); w.y = cvtpk(va[j].z, va[j].w); ((u32x2*)(XB + (size_t)m * DM) + lane)[64 * j] = w;
                    u32x2 wl; wl.x = cvtpk(va[j].x - bflo(w.x), va[j].y - bfhi(w.x)); wl.y = cvtpk(va[j].z - bflo(w.y), va[j].w - bfhi(w.y)); ((u32x2*)(LOD + (size_t)m * DM) + lane)[64 * j] = wl;
                    if (two) { u32x2 w2; w2.x = cvtpk(vb[j].x, vb[j].y); w2.y = cvtpk(vb[j].z, vb[j].w); ((u32x2*)(XB + (size_t)m2 * DM) + lane)[64 * j] = w2;
                        u32x2 wl2; wl2.x = cvtpk(vb[j].x - bflo(w2.x), vb[j].y - bfhi(w2.x)); wl2.y = cvtpk(vb[j].z - bflo(w2.y), vb[j].w - bfhi(w2.y)); ((u32x2*)(LOD + (size_t)m2 * DM) + lane)[64 * j] = wl2; } }
                if (lane < 16) { (SSA + (size_t)m * 16)[lane] = (lane == 0) ? sa : 0.f; if (two) (SSA + (size_t)m2 * 16)[lane] = (lane == 0) ? sbq : 0.f; }
            }
            convert_first(a, 0, scr, gw, ngw, lane);
            break;
        case 0:
            g = pg8::Gemm{XB, WIN, MROWS, 4608, 1024, 1024, 0, 0}; E = pg8::EpiAny{0, Z1, ZP, ZP, ss1, nullptr, nullptr, nullptr, nullptr}; is_gemm = true; break;
        case 1:
            convert_second(a, l, scr, gw, ngw, lane);
            __syncthreads();
            for (int it = bid; it < 1824; it += G) {
                int t2 = tid; asm volatile("" : "+v"(t2));
                if (it < 256) sgu_item(a, l, it, lds, t2);
                else if (it < 768) prep_item(a, l, it - 256, lds, t2);
                else if (it < 1280) mix_ac_item(a, l, it - 768, t2);
                else compress_item(a, l, it - 1280, lds, t2);
            }
            break;
        case 2:
            for (int pr0 = bid; pr0 < NB * 2 * 32; pr0 += G) {
                int pr = pr0; if (G == 256) { const int k = pr0 >> 8, x = pr0 & 7, slot = (pr0 >> 3) & 31; pr = ((x + 8 * k) << 5) | slot; }
                const int b = pr >> 6, gg = (pr >> 5) & 1, tb = pr & 31;
                nsa_wg_unit(a, l, b, gg, tb, lds, tid, true); nsa_wg_unit(a, l, b, gg, 63 - tb, lds, tid, false); }
            __syncthreads();
            break;
        case 3:
            g = pg8::Gemm{OUTS, WB, MROWS, 4096, 512, 512, 2, (size_t)MROWS * 512 * 2}; E = pg8::EpiAny{0, Z1, 4096, 4096, nullptr, nullptr, nullptr, nullptr, nullptr}; is_gemm = true; break;
        case 4:
            g = pg8::Gemm{XB, WIN + (size_t)4608 * 1024, MROWS, 4096, 1024, 1024, 0, 0}; E = pg8::EpiAny{2, OUTS, 0, 0, ss1, (const float*)Z1, nullptr, nullptr, nullptr}; is_gemm = true; break;
        case 5:
            g = pg8::Gemm{OUTS, WO, MROWS, 1024, 1024, 1024, 0, 0}; E = pg8::EpiAny{3, XB, 0, 0, (const float*)(l + 1 < DEPTH ? LOD : LOW), (const float*)LOD, nullptr, ss2, nullptr}; is_gemm = true; break;
        case 6:
            g = pg8::Gemm{XB, WUP, MROWS, GUP, 1024, 1024, 0, 0}; E = pg8::EpiAny{4, Z1, 0, 0, ss2, a.in[17] + (size_t)l * 3 * DFF, WSP(float, WS_SB), nullptr, (PG8_LAS float*)(glds + 131072)}; is_gemm = true; break;
        case 7:
            act_fixup(a, l, gtid, ngt);
            if (l + 1 < DEPTH) convert_first(a, l + 1, scr, gw, ngw, lane);
            break;
        default:
            g = pg8::Gemm{Z1, WDN, MROWS, 1024, DFF, DFF, 0, 0}; E = pg8::EpiAny{3, XB, 0, 0, (const float*)LOD, (const float*)(l + 1 < DEPTH ? LOD : LOW), l + 1 < DEPTH ? (float*)nullptr : a.out, ss3, nullptr}; is_gemm = true; break;
        }
        if (is_gemm) { pg8::StaticOrder S; S.init(MROWS, g.N, G, bid); S.rev = (k == 4 || k == 8) ? 1 : 0; pg8::gemm_phase<pg8::EpiAny, pg8::StaticOrder, true, true>(glds, g, S, E); }
    }
}

#ifndef MK_MULTI
#define MK_MULTI 0
#endif
extern "C" void kernel_launch(void* const* d_in, const int* in_sizes, int n_in, void* d_out, int out_size, void* d_ws, size_t ws_size, hipStream_t stream) {
    static int grid = 0;
    if (grid == 0) {
        if (n_in != 19 || out_size != MROWS * DM || ws_size < WS_NEED) { fprintf(stderr, "kernel_launch: unexpected problem: n_in %d out %d ws %zu (need %zu)\n", n_in, out_size, ws_size, (size_t)WS_NEED); grid = -1; return; }
        int dev = 0, cus = 0, per_cu = 0;
        hipGetDevice(&dev); hipDeviceGetAttribute(&cus, hipDeviceAttributeMultiprocessorCount, dev);
        if (hipFuncSetAttribute((const void*)fwd_kernel, hipFuncAttributeMaxDynamicSharedMemorySize, LDS_BYTES) != hipSuccess) { fprintf(stderr, "kernel_launch: hipFuncSetAttribute failed\n"); grid = -1; return; }
        if (hipOccupancyMaxActiveBlocksPerMultiprocessor(&per_cu, (const void*)fwd_kernel, 512, LDS_BYTES) != hipSuccess || per_cu < 1) { fprintf(stderr, "kernel_launch: occupancy query failed (%d)\n", per_cu); per_cu = 1; (void)hipGetLastError(); }
        grid = cus * 1;
        (void)per_cu;
    }
    if (grid < 0) return;
    if (hipMemsetAsync((char*)d_ws + WS_CTL, 0, CTL_BYTES, stream) != hipSuccess) { fprintf(stderr, "kernel_launch: memset failed\n"); return; }
    Args a{};
    for (int i = 0; i < 19; ++i) a.in[i] = (const float*)d_in[i];
    a.out = (float*)d_out; a.ws = (unsigned char*)d_ws;
#if MK_MULTI
    for (int p = 0; p < N_PHASES; ++p) { a.ph_lo = p; a.ph_hi = p + 1; a.coop = 0; a.pad = 0; hipLaunchKernelGGL(fwd_kernel, dim3(grid), dim3(512), LDS_BYTES, stream, a); }
#else
    a.ph_lo = 0; a.ph_hi = N_PHASES; a.coop = 1; a.pad = 0;
    void* args[] = {&a};
    hipError_t e = hipLaunchCooperativeKernel((const void*)fwd_kernel, dim3(grid), dim3(512), args, LDS_BYTES, stream);
    if (e != hipSuccess) fprintf(stderr, "kernel_launch: cooperative launch failed: %s (grid %d)\n", hipGetErrorString(e), grid);
#endif
}
```
